# Optimizing an MI355X kernel written in HIP

```python
import jax, jax.numpy as jnp
from jax import lax
import numpy as np

D_MODEL = 1024
BATCH = 4
SEQ = 4096
DEPTH = 2

CHUNK = 64
N_MIXERS = 2
N_POOL_LAYERS = (DEPTH + N_MIXERS - 1) // N_MIXERS
N_GLA_LAYERS = DEPTH // N_MIXERS

POOL_WIDTH = D_MODEL
POOL_WINDOWS = (2, 4, 8, 16)
POOL_GROUPS = len(POOL_WINDOWS)
POOL_GROUP_DIM = POOL_WIDTH // POOL_GROUPS

GLA_HEADS = 4
GLA_KEY_WIDTH = D_MODEL // 2
GLA_VALUE_WIDTH = D_MODEL
GLA_HEAD_K = GLA_KEY_WIDTH // GLA_HEADS
GLA_HEAD_V = GLA_VALUE_WIDTH // GLA_HEADS
GLA_GATE_RANK = 16
GLA_GATE_NORMALIZER = 16.0
GLA_IN_WIDTH = 2 * GLA_KEY_WIDTH + 2 * GLA_VALUE_WIDTH + GLA_GATE_RANK

RMS_EPS = 1e-6

kernel_name = "hybrid_pool_gla_streaming_trunk"


def rms_norm(x, w):
    xf = x.astype(jnp.float32)
    y = xf * lax.rsqrt(jnp.mean(xf * xf, axis=-1, keepdims=True) + RMS_EPS)
    return (y * w.astype(jnp.float32)).astype(x.dtype)


def trailing_mean(u, window):
    seq = u.shape[1]
    cs = jnp.cumsum(u.astype(jnp.float32), axis=1)
    lagged = jnp.pad(cs, ((0, 0), (window, 0), (0, 0)))[:, :seq]
    count = jnp.minimum(jnp.arange(1, seq + 1), window).astype(jnp.float32)
    return ((cs - lagged) / count[None, :, None]).astype(u.dtype)


def pool_mixer(h, in_w, group_w, group_b, scale, out_w):
    b, s, _ = h.shape
    u, gate = jnp.split(h @ in_w, 2, axis=-1)
    ug = u.reshape(b, s, POOL_GROUPS, POOL_GROUP_DIM)
    pooled = jnp.stack([trailing_mean(ug[:, :, g], w) for g, w in enumerate(POOL_WINDOWS)],
                       axis=2) - ug
    mixed = jnp.einsum('bsgc,gcd->bsgd', pooled, group_w) + group_b
    y = mixed.reshape(b, s, POOL_WIDTH) * scale * jax.nn.silu(gate)
    return y @ out_w


def gla_mixer(h, in_w, gk_w, gk_b, head_norm_w, out_w):
    b, s, _ = h.shape
    n_chunks = s // CHUNK
    f32 = jnp.float32
    proj = h @ in_w
    q, k, v, gate, gk_low = jnp.split(
        proj, [GLA_KEY_WIDTH, 2 * GLA_KEY_WIDTH, 2 * GLA_KEY_WIDTH + GLA_VALUE_WIDTH,
               2 * GLA_KEY_WIDTH + 2 * GLA_VALUE_WIDTH], axis=-1)
    log_g = jax.nn.log_sigmoid((gk_low @ gk_w + gk_b).astype(f32)) / GLA_GATE_NORMALIZER

    def to_chunks(t, d):
        return t.astype(f32).reshape(b, n_chunks, CHUNK, GLA_HEADS, d)

    qc = to_chunks(q, GLA_HEAD_K) * (GLA_HEAD_K ** -0.5)
    kc = to_chunks(k, GLA_HEAD_K)
    vc = to_chunks(v, GLA_HEAD_V)
    cum = jnp.cumsum(to_chunks(log_g, GLA_HEAD_K), axis=2)
    cum_last = cum[:, :, -1:]
    e_pos, e_neg = jnp.exp(cum), jnp.exp(-cum)

    fwd = jnp.einsum('bnthk,bnshk->bnhts', qc * e_pos, kc * e_neg)
    bwd = jnp.einsum('bnthk,bnshk->bnhts', qc * e_neg, kc * e_pos)
    idx = jnp.arange(CHUNK)
    lower = idx[:, None] >= idx[None, :]
    scores = jnp.where(lower, fwd, bwd)
    o_intra = jnp.einsum('bnhts,bnshv->bnthv', scores, vc)

    q_dec = qc * e_pos
    k_dec = kc * jnp.exp(cum_last - cum)
    chunk_decay = jnp.exp(cum_last[:, :, 0])

    def step(state, inp):
        q_n, k_n, v_n, d_n = inp
        o_n = jnp.einsum('bthk,bhkv->bthv', q_n, state)
        state = state * d_n[..., None] + jnp.einsum('bthk,bthv->bhkv', k_n, v_n)
        return state, o_n

    xs = (jnp.moveaxis(q_dec, 1, 0), jnp.moveaxis(k_dec, 1, 0),
          jnp.moveaxis(vc, 1, 0), jnp.moveaxis(chunk_decay, 1, 0))
    state0 = jnp.zeros((b, GLA_HEADS, GLA_HEAD_K, GLA_HEAD_V), f32)
    _, o_inter = lax.scan(step, state0, xs)
    o = (o_intra + jnp.moveaxis(o_inter, 0, 1)).reshape(b, s, GLA_HEADS, GLA_HEAD_V)

    o = o * lax.rsqrt(jnp.mean(o * o, axis=-1, keepdims=True) + RMS_EPS) * head_norm_w.astype(f32)
    y = o.reshape(b, s, GLA_VALUE_WIDTH).astype(h.dtype) * jax.nn.silu(gate)
    return y @ out_w


def setup_inputs(seed: int = 0) -> dict:
    key = jax.random.key(seed)
    ks = jax.random.split(key, 16)
    nrm = jax.random.normal
    f32 = jnp.float32
    NP, NG = N_POOL_LAYERS, N_GLA_LAYERS
    return {
        "x": nrm(ks[0], (BATCH, SEQ, D_MODEL), f32),
        "norm_w": 1.0 + 0.02 * nrm(ks[1], (DEPTH, D_MODEL), f32),
        "pool_in_w": nrm(ks[2], (NP, D_MODEL, 2 * POOL_WIDTH), f32) * D_MODEL ** -0.5,
        "pool_group_w": nrm(ks[3], (NP, POOL_GROUPS, POOL_GROUP_DIM, POOL_GROUP_DIM), f32) * POOL_GROUP_DIM ** -0.5,
        "pool_group_b": 0.02 * nrm(ks[4], (NP, POOL_GROUPS, POOL_GROUP_DIM), f32),
        "pool_scale": 1.0 + 0.1 * nrm(ks[5], (NP, POOL_WIDTH), f32),
        "pool_out_w": nrm(ks[6], (NP, POOL_WIDTH, D_MODEL), f32) * POOL_WIDTH ** -0.5,
        "gla_in_w": nrm(ks[7], (NG, D_MODEL, GLA_IN_WIDTH), f32) * D_MODEL ** -0.5,
        "gla_gk_w": nrm(ks[8], (NG, GLA_GATE_RANK, GLA_KEY_WIDTH), f32) * GLA_GATE_RANK ** -0.5,
        "gla_gk_b": 0.02 * nrm(ks[9], (NG, GLA_KEY_WIDTH), f32),
        "gla_head_norm_w": 1.0 + 0.02 * nrm(ks[10], (NG, GLA_HEAD_V), f32),
        "gla_out_w": nrm(ks[11], (NG, GLA_VALUE_WIDTH, D_MODEL), f32) * GLA_VALUE_WIDTH ** -0.5,
        "final_norm_w": 1.0 + 0.02 * nrm(ks[12], (D_MODEL,), f32),
    }


def reference(x, norm_w, pool_in_w, pool_group_w, pool_group_b, pool_scale, pool_out_w,
              gla_in_w, gla_gk_w, gla_gk_b, gla_head_norm_w, gla_out_w, final_norm_w):
    h = x
    for i in range(DEPTH):
        normed = rms_norm(h, norm_w[i])
        j = i // N_MIXERS
        if i % N_MIXERS == 0:
            h = h + pool_mixer(normed, pool_in_w[j], pool_group_w[j], pool_group_b[j],
                               pool_scale[j], pool_out_w[j])
        else:
            h = h + gla_mixer(normed, gla_in_w[j], gla_gk_w[j], gla_gk_b[j],
                              gla_head_norm_w[j], gla_out_w[j])
    return rms_norm(h, final_norm_w)
```

```cpp
#include <hip/hip_runtime.h>
#include <cstdio>
#include <cstdint>

namespace ref {
constexpr int D = 1024, SEQ = 4096, BATCH = 4, CHUNK = 64;
constexpr int PW = 1024, GIN = 3088, KW = 512, VW = 1024, HK = 128, HV = 256, NH = 4, RANK = 16;
constexpr float EPS = 1e-6f;

__device__ __forceinline__ float wave_sum(float v) {
#pragma unroll
    for (int o = 1; o < 64; o <<= 1) v += __shfl_xor(v, o);
    return v;
}
__device__ __forceinline__ float silu(float x) { return x / (1.f + __expf(-x)); }

__global__ void __launch_bounds__(256) k_rstd(const float* __restrict__ x, float* __restrict__ rstd, int rows) {
    const int w = (blockIdx.x * 256 + threadIdx.x) >> 6, lane = threadIdx.x & 63;
    if (w >= rows) return;
    const float4* xr = (const float4*)(x + (size_t)w * D);
    float s = 0.f;
#pragma unroll
    for (int j = 0; j < 4; ++j) { const float4 v = xr[lane + 64 * j]; s += v.x * v.x + v.y * v.y + v.z * v.z + v.w * v.w; }
    s = wave_sum(s);
    if (lane == 0) rstd[w] = rsqrtf(s * (1.f / D) + EPS);
}

__global__ void __launch_bounds__(256) k_gemm(const float* __restrict__ A, int lda, const float* __restrict__ B, int ldb, float* C, int ldc,
                                              int M, int N, int K, const float* __restrict__ rs, const float* __restrict__ ks, const float* R, int ldr) {
    __shared__ float As[16][65];
    __shared__ float Bs[16][65];
    const int tid = threadIdx.x, tx = tid & 15, ty = tid >> 4;
    const int m0 = blockIdx.y * 64, n0 = blockIdx.x * 64;
    float acc[4][4];
#pragma unroll
    for (int i = 0; i < 4; ++i)
#pragma unroll
        for (int j = 0; j < 4; ++j) acc[i][j] = 0.f;
    for (int k0 = 0; k0 < K; k0 += 16) {
#pragma unroll
        for (int i = 0; i < 4; ++i) {
            const int e = tid + i * 256, r = e >> 4, c = e & 15;
            float a = A[(size_t)(m0 + r) * lda + k0 + c];
            if (ks) a *= ks[k0 + c];
            As[c][r] = a;
            const int br = e >> 6, bc = e & 63;
            Bs[br][bc] = (n0 + bc < N) ? B[(size_t)(k0 + br) * ldb + n0 + bc] : 0.f;
        }
        __syncthreads();
#pragma unroll
        for (int k = 0; k < 16; ++k) {
            float a[4], b[4];
#pragma unroll
            for (int i = 0; i < 4; ++i) { a[i] = As[k][ty * 4 + i]; b[i] = Bs[k][tx * 4 + i]; }
#pragma unroll
            for (int i = 0; i < 4; ++i)
#pragma unroll
                for (int j = 0; j < 4; ++j) acc[i][j] += a[i] * b[j];
        }
        __syncthreads();
    }
#pragma unroll
    for (int i = 0; i < 4; ++i) {
        const int m = m0 + ty * 4 + i;
        const float s = rs ? rs[m] : 1.f;
#pragma unroll
        for (int j = 0; j < 4; ++j) {
            const int n = n0 + tx * 4 + j;
            if (n < N) { float v = acc[i][j] * s; if (R) v += R[(size_t)m * ldr + n]; C[(size_t)m * ldc + n] = v; }
        }
    }
}

__global__ void __launch_bounds__(256) k_pool(const float* __restrict__ P, float* __restrict__ pooled, int rows) {
    const size_t i = (size_t)blockIdx.x * 256 + threadIdx.x;
    if (i >= (size_t)rows * PW) return;
    const int t = (int)(i / PW), c = (int)(i % PW);
    const int w = 2 << (c >> 8), pos = t % SEQ, cnt = pos + 1 < w ? pos + 1 : w;
    float s = 0.f;
    for (int j = 0; j < cnt; ++j) s += P[(size_t)(t - j) * 2048 + c];
    pooled[i] = s / (float)cnt - P[(size_t)t * 2048 + c];
}
__global__ void __launch_bounds__(256) k_gate0(float* mixed, const float* __restrict__ P, const float* __restrict__ gb, const float* __restrict__ sc, int rows) {
    const size_t i = (size_t)blockIdx.x * 256 + threadIdx.x;
    if (i >= (size_t)rows * PW) return;
    const int t = (int)(i / PW), c = (int)(i % PW);
    mixed[i] = (mixed[i] + gb[c]) * sc[c] * silu(P[(size_t)t * 2048 + 1024 + c]);
}
__global__ void __launch_bounds__(256) k_cum(const float* __restrict__ proj, const float* __restrict__ gkw, const float* __restrict__ gkb, float* __restrict__ cum, int nchunks) {
    const int i = blockIdx.x * 256 + threadIdx.x;
    if (i >= nchunks * KW) return;
    const int ch = i / KW, kw = i % KW;
    float w[RANK];
#pragma unroll
    for (int r = 0; r < RANK; ++r) w[r] = gkw[r * KW + kw];
    const float b = gkb[kw];
    float run = 0.f;
    for (int t = 0; t < CHUNK; ++t) {
        const float* g = proj + (size_t)(ch * CHUNK + t) * GIN + 3072;
        float z = b;
#pragma unroll
        for (int r = 0; r < RANK; ++r) z += g[r] * w[r];
        const float ls = fminf(z, 0.f) - log1pf(__expf(-fabsf(z)));
        run += ls * (1.f / 16.f);
        cum[(size_t)(ch * CHUNK + t) * KW + kw] = run;
    }
}
__global__ void __launch_bounds__(256) k_prep(const float* __restrict__ proj, const float* __restrict__ cum, float* qp, float* qn, float* kp, float* kn, float* kd, float* decay, int rows) {
    const size_t i = (size_t)blockIdx.x * 256 + threadIdx.x;
    if (i >= (size_t)rows * KW) return;
    const int t = (int)(i / KW), kw = (int)(i % KW);
    const float c = cum[i], cl = cum[(size_t)((t / CHUNK) * CHUNK + CHUNK - 1) * KW + kw];
    const float q = proj[(size_t)t * GIN + kw] * 0.08838834764831845f, k = proj[(size_t)t * GIN + 512 + kw];
    const float ep = __expf(c), en = __expf(-c);
    qp[i] = q * ep; qn[i] = q * en; kp[i] = k * ep; kn[i] = k * en; kd[i] = k * __expf(cl - c);
    if ((t % CHUNK) == CHUNK - 1) decay[(size_t)(t / CHUNK) * KW + kw] = __expf(cl);
}
__global__ void __launch_bounds__(256) k_scores(const float* __restrict__ qp, const float* __restrict__ qn, const float* __restrict__ kp, const float* __restrict__ kn, float* __restrict__ scores) {
    __shared__ float sq[2][64][33];
    __shared__ float sk[2][64][33];
    const int ch = blockIdx.x >> 2, h = blockIdx.x & 3, tid = threadIdx.x;
    const int t = tid >> 2, sb = tid & 3;
    float acc[16];
#pragma unroll
    for (int j = 0; j < 16; ++j) acc[j] = 0.f;
    for (int k0 = 0; k0 < HK; k0 += 32) {
#pragma unroll
        for (int i = 0; i < 8; ++i) {
            const int e = tid + i * 256, r = e >> 5, c = e & 31;
            const size_t g = (size_t)(ch * CHUNK + r) * KW + h * HK + k0 + c;
            sq[0][r][c] = qp[g]; sq[1][r][c] = qn[g]; sk[0][r][c] = kn[g]; sk[1][r][c] = kp[g];
        }
        __syncthreads();
#pragma unroll
        for (int j = 0; j < 16; ++j) {
            const int s = sb + 4 * j, sel = (s <= t) ? 0 : 1;
            float a = 0.f;
#pragma unroll
            for (int k = 0; k < 32; ++k) a += sq[sel][t][k] * sk[sel][s][k];
            acc[j] += a;
        }
        __syncthreads();
    }
#pragma unroll
    for (int j = 0; j < 16; ++j) scores[((size_t)blockIdx.x * 64 + t) * 64 + sb + 4 * j] = acc[j];
}
__global__ void __launch_bounds__(256) k_gla_seq(const float* __restrict__ qp, const float* __restrict__ kd, const float* __restrict__ scores, const float* __restrict__ decay,
                                                 const float* __restrict__ proj, float* __restrict__ o, int chunks_per_seq) {
    __shared__ float st[128][16];
    __shared__ float X[64][129];
    __shared__ float sc[64][65];
    __shared__ float vv[64][16];
    const int vs = blockIdx.x & 15, h = (blockIdx.x >> 4) & 3, b = blockIdx.x >> 6, tid = threadIdx.x;
    for (int i = tid; i < 128 * 16; i += 256) st[i >> 4][i & 15] = 0.f;
    for (int n = 0; n < chunks_per_seq; ++n) {
        const int ch = b * chunks_per_seq + n; const size_t t0 = (size_t)ch * CHUNK;
        __syncthreads();
        for (int i = tid; i < 64 * 128; i += 256) { const int r = i >> 7, c = i & 127; X[r][c] = qp[(t0 + r) * KW + h * HK + c]; }
        for (int i = tid; i < 64 * 64; i += 256) { const int r = i >> 6, c = i & 63; sc[r][c] = scores[((size_t)(ch * 4 + h) * 64 + r) * 64 + c]; }
        for (int i = tid; i < 64 * 16; i += 256) { const int r = i >> 4, c = i & 15; vv[r][c] = proj[(t0 + r) * GIN + 1024 + h * HV + vs * 16 + c]; }
        __syncthreads();
        {
            const int t = tid >> 2, v0 = (tid & 3) * 4;
            float a[4] = {0.f, 0.f, 0.f, 0.f};
            for (int s = 0; s < 64; ++s) { const float w = sc[t][s];
#pragma unroll
                for (int j = 0; j < 4; ++j) a[j] += w * vv[s][v0 + j]; }
            for (int k = 0; k < 128; ++k) { const float w = X[t][k];
#pragma unroll
                for (int j = 0; j < 4; ++j) a[j] += w * st[k][v0 + j]; }
#pragma unroll
            for (int j = 0; j < 4; ++j) o[(t0 + t) * VW + h * HV + vs * 16 + v0 + j] = a[j];
        }
        __syncthreads();
        for (int i = tid; i < 64 * 128; i += 256) { const int r = i >> 7, c = i & 127; X[r][c] = kd[(t0 + r) * KW + h * HK + c]; }
        __syncthreads();
        {
            const int k = tid >> 1, v0 = (tid & 1) * 8;
            const float dk = decay[(size_t)ch * KW + h * HK + k];
            float a[8];
#pragma unroll
            for (int j = 0; j < 8; ++j) a[j] = st[k][v0 + j] * dk;
            for (int t = 0; t < 64; ++t) { const float w = X[t][k];
#pragma unroll
                for (int j = 0; j < 8; ++j) a[j] += w * vv[t][v0 + j]; }
#pragma unroll
            for (int j = 0; j < 8; ++j) st[k][v0 + j] = a[j];
        }
    }
}
__global__ void __launch_bounds__(256) k_headnorm(float* o, const float* __restrict__ proj, const float* __restrict__ hnw, int rows) {
    const int w = (blockIdx.x * 256 + threadIdx.x) >> 6, lane = threadIdx.x & 63;
    if (w >= rows * NH) return;
    const int t = w >> 2, h = w & 3;
    float4* p = (float4*)(o + (size_t)t * VW + h * HV) + lane;
    float4 v = *p;
    const float s = wave_sum(v.x * v.x + v.y * v.y + v.z * v.z + v.w * v.w);
    const float r = rsqrtf(s * (1.f / HV) + EPS);
    const float4 g = *((const float4*)(proj + (size_t)t * GIN + 2048 + h * HV) + lane);
    const float4 wv = *((const float4*)hnw + lane);
    v.x = v.x * r * wv.x * silu(g.x); v.y = v.y * r * wv.y * silu(g.y); v.z = v.z * r * wv.z * silu(g.z); v.w = v.w * r * wv.w * silu(g.w);
    *p = v;
}
__global__ void __launch_bounds__(256) k_final(float* x, const float* __restrict__ w, int rows) {
    const int r = (blockIdx.x * 256 + threadIdx.x) >> 6, lane = threadIdx.x & 63;
    if (r >= rows) return;
    float4* xr = (float4*)(x + (size_t)r * D);
    float4 v[4]; float s = 0.f;
#pragma unroll
    for (int j = 0; j < 4; ++j) { v[j] = xr[lane + 64 * j]; s += v[j].x * v[j].x + v[j].y * v[j].y + v[j].z * v[j].z + v[j].w * v[j].w; }
    const float rs = rsqrtf(wave_sum(s) * (1.f / D) + EPS);
#pragma unroll
    for (int j = 0; j < 4; ++j) { const float4 ww = ((const float4*)w)[lane + 64 * j];
        v[j].x *= rs * ww.x; v[j].y *= rs * ww.y; v[j].z *= rs * ww.z; v[j].w *= rs * ww.w; xr[lane + 64 * j] = v[j]; }
}

inline void gemm(hipStream_t st, const float* A, int lda, const float* B, int ldb, float* C, int ldc, int M, int N, int K, const float* rs, const float* ks, const float* R, int ldr) {
    k_gemm<<<dim3((N + 63) / 64, M / 64), 256, 0, st>>>(A, lda, B, ldb, C, ldc, M, N, K, rs, ks, R, ldr);
}

inline void forward(void* const* d_in, float* out, unsigned char* ws, hipStream_t st, int t0, int rows) {
    const float* x = (const float*)d_in[0] + (size_t)t0 * D;
    const float* norm_w = (const float*)d_in[1];
    const float* pin = (const float*)d_in[2];
    const float* pgw = (const float*)d_in[3];
    const float* pgb = (const float*)d_in[4];
    const float* psc = (const float*)d_in[5];
    const float* pout = (const float*)d_in[6];
    const float* gin = (const float*)d_in[7];
    const float* gkw = (const float*)d_in[8];
    const float* gkb = (const float*)d_in[9];
    const float* hnw = (const float*)d_in[10];
    const float* gout = (const float*)d_in[11];
    const float* fw = (const float*)d_in[12];
    float* o_ = out + (size_t)t0 * D;
    const size_t MB = 1u << 20;
    float* P0 = (float*)(ws);
    float* pooled = (float*)(ws + 32 * MB);
    float* mixed = (float*)(ws + 48 * MB);
    float* rstd = (float*)(ws + 124 * MB);
    float* proj = (float*)(ws);
    float* cum = (float*)(ws + 52 * MB);
    float* qp = (float*)(ws + 60 * MB), *qn = (float*)(ws + 68 * MB), *kp = (float*)(ws + 76 * MB), *kn = (float*)(ws + 84 * MB), *kd = (float*)(ws + 92 * MB);
    float* scores = (float*)(ws + 100 * MB);
    float* decay = (float*)(ws + 104 * MB);
    float* o = (float*)(ws + 106 * MB);
    const int nchunks = rows / CHUNK;
    k_rstd<<<rows / 4, 256, 0, st>>>(x, rstd, rows);
    gemm(st, x, D, pin, 2048, P0, 2048, rows, 2048, D, rstd, norm_w, nullptr, 0);
    k_pool<<<(rows * PW) / 256, 256, 0, st>>>(P0, pooled, rows);
    for (int g = 0; g < 4; ++g) gemm(st, pooled + g * 256, PW, pgw + (size_t)g * 65536, 256, mixed + g * 256, PW, rows, 256, 256, nullptr, nullptr, nullptr, 0);
    k_gate0<<<(rows * PW) / 256, 256, 0, st>>>(mixed, P0, pgb, psc, rows);
    gemm(st, mixed, PW, pout, D, o_, D, rows, D, PW, nullptr, nullptr, x, D);
    k_rstd<<<rows / 4, 256, 0, st>>>(o_, rstd, rows);
    gemm(st, o_, D, gin, GIN, proj, GIN, rows, GIN, D, rstd, norm_w + D, nullptr, 0);
    k_cum<<<(nchunks * KW) / 256, 256, 0, st>>>(proj, gkw, gkb, cum, nchunks);
    k_prep<<<(rows * KW) / 256, 256, 0, st>>>(proj, cum, qp, qn, kp, kn, kd, decay, rows);
    k_scores<<<nchunks * 4, 256, 0, st>>>(qp, qn, kp, kn, scores);
    k_gla_seq<<<(rows / SEQ) * 64, 256, 0, st>>>(qp, kd, scores, decay, proj, o, SEQ / CHUNK);
    k_headnorm<<<rows, 256, 0, st>>>(o, proj, hnw, rows);
    gemm(st, o, VW, gout, D, o_, D, rows, D, VW, nullptr, nullptr, o_, D);
    k_final<<<rows / 4, 256, 0, st>>>(o_, fw, rows);
}
}

extern "C" void kernel_launch(void* const* d_in, const int* in_sizes, int n_in, void* d_out, int out_size, void* d_ws, size_t ws_size, hipStream_t stream) {
    for (int b = 0; b < ref::BATCH; ++b) ref::forward(d_in, (float*)d_out, (unsigned char*)d_ws, stream, b * ref::SEQ, ref::SEQ);
}
```

```cpp
#include <hip/hip_runtime.h>
#include <cstdio>
#include <cstdint>
#define DBG 0
#define DBG_ONLY 0
namespace pg8 {
#define PG8_LAS __attribute__((address_space(3)))
typedef unsigned short bf16_t;
typedef short bf16x8 __attribute__((ext_vector_type(8)));
typedef float f32x4 __attribute__((ext_vector_type(4)));
typedef float f32x2 __attribute__((ext_vector_type(2)));
typedef unsigned u32x4 __attribute__((ext_vector_type(4)));
typedef unsigned u32x2 __attribute__((ext_vector_type(2)));
constexpr int BM = 256, BK = 64, HALF = 128, HTB = HALF * BK * 2, STAGE_BYTES = 8 * HTB, NXCD = 8, WGM = 8;

__host__ __device__ __forceinline__ int lds_byte(int r, int c) { const int st = (r >> 4) * 2 + (c >> 5), rr = r & 15, cc = c & 31, ob = rr * 64 + cc * 2; return st * 1024 + (ob ^ (((ob >> 9) & 1) << 5)); }
__host__ __device__ __forceinline__ void stage_rc(int b, int& R, int& C) { const int st = b / 1024, sb = b % 1024, swz = sb ^ (((sb >> 9) & 1) << 5); R = (st >> 1) * 16 + swz / 64; C = (st & 1) * 32 + (swz % 64) / 2; }
__host__ __device__ __forceinline__ int perm32(int rho) { const int n = rho >> 4, i = rho & 15; return 8 * (i >> 2) + 4 * n + (i & 3); }

struct Unit { int pm, pn; };
struct Gemm { const bf16_t* A; const bf16_t* Bt; int lda, ldb, K, apn; };

struct StaticOrder {
    int nM, nN, nwg, G, c;
    __host__ __device__ void init(int M, int N, int G_, int c_) { nM = M / BM; nN = N / BM; nwg = nM * nN; G = G_; c = c_; }
    __host__ __device__ bool next(int i, Unit& u) const {
        const long L = (long)i * G + c; if (L >= nwg) return false;
        int wgid = (int)L; { const int q = nwg / NXCD, r = nwg % NXCD, xcd = wgid % NXCD, off = wgid / NXCD; wgid = (xcd < r ? xcd * (q + 1) : r * (q + 1) + (xcd - r) * q) + off; }
        const int nig = WGM * nN, gid = wgid / nig, fm = gid * WGM, gsz = (nM - fm) < WGM ? (nM - fm) : WGM;
        u.pm = fm + ((wgid % nig) % gsz); u.pn = (wgid % nig) / gsz; return true;
    }
};

__device__ __forceinline__ unsigned cvt_pk_bf16(float lo, float hi) { unsigned r; asm volatile("v_cvt_pk_bf16_f32 %0, %1, %2" : "=v"(r) : "v"(lo), "v"(hi)); return r; }

template <class Epi, bool ALIGN_EPI>
__device__ __forceinline__ void gemm_phase(PG8_LAS unsigned char* lds, const Gemm g, const StaticOrder& S, const Epi& E) {
    int tid_ = threadIdx.x; asm volatile("" : "+v"(tid_));
    const int tid = tid_, wid = __builtin_amdgcn_readfirstlane(tid >> 6), lane = tid & 63, wr = wid >> 2, wc = wid & 3, fr = lane & 15, fq = lane >> 4;
    int K_ = g.K; asm volatile("" : "+s"(K_));
    const int K = K_, nt = K / BK;
    unsigned voffA[2], voffB[2];
#pragma unroll
    for (int i = 0; i < 2; ++i) { int R, C; stage_rc(tid * 16 + i * 8192, R, C); const int Rb = Epi::PERM ? ((R & ~31) + perm32(R & 31)) : R;
        voffA[i] = (unsigned)(R * g.lda + C) * 2u; voffB[i] = (unsigned)(Rb * g.ldb + C) * 2u; }
    const size_t kstep = (size_t)(BK * 2);
    const size_t hA = (size_t)HALF * g.lda * 2, hB = (size_t)HALF * g.ldb * 2;
    const unsigned ldsw = (unsigned)wid * 1024u;
    const int aoff = lds_byte(wr * 64 + fr, fq * 8), boff = lds_byte(wc * 32 + fr, fq * 8);
#define PG8_UA(u) ((const char*)g.A + ((size_t)(u).pm * 256 * g.lda + (size_t)(u).pn * g.apn) * 2)
#define PG8_UB(u) ((const char*)g.Bt + ((size_t)(u).pn * 256 * g.ldb) * 2)
#define PG8_SA(b, h) (((b) * 2 + (h)) * HTB)
#define PG8_SB(b, h) ((4 + (b) * 2 + (h)) * HTB)
#define PG8_STAGE(bufoff, gbase, voff) do { _Pragma("unroll") for (int _i = 0; _i < 2; ++_i) \
        __builtin_amdgcn_global_load_lds((const unsigned*)((const char*)(gbase) + (voff)[_i]), (PG8_LAS unsigned*)(lds + (bufoff) + ldsw + _i * 8192), 16, 0, 0); } while (0)
#define PG8_LDA(dst, b, h) do { _Pragma("unroll") for (int m = 0; m < 4; ++m) _Pragma("unroll") for (int k = 0; k < 2; ++k) dst[m][k] = *(const PG8_LAS bf16x8*)(lds + PG8_SA(b, h) + aoff + m * 2048 + k * 1024); } while (0)
#define PG8_LDB(dst, b, h) do { _Pragma("unroll") for (int n = 0; n < 2; ++n) _Pragma("unroll") for (int k = 0; k < 2; ++k) dst[n][k] = *(const PG8_LAS bf16x8*)(lds + PG8_SB(b, h) + boff + n * 2048 + k * 1024); } while (0)
#define PG8_MMA(ai, bj, At, Bt) do { __builtin_amdgcn_s_setprio(1); _Pragma("unroll") for (int m = 0; m < 4; ++m) _Pragma("unroll") for (int n = 0; n < 2; ++n) _Pragma("unroll") for (int k = 0; k < 2; ++k) \
        acc[ai][bj][m][n] = __builtin_amdgcn_mfma_f32_16x16x32_bf16(Bt[n][k], At[m][k], acc[ai][bj][m][n], 0, 0, 0); __builtin_amdgcn_s_setprio(0); } while (0)
#define PG8_WAIT_V(n) asm volatile("s_waitcnt vmcnt(" #n ")" ::: "memory")
#define PG8_WAIT_L(n) asm volatile("s_waitcnt lgkmcnt(" #n ")" ::: "memory")
#define PG8_BAR __builtin_amdgcn_s_barrier()
#define PG8_SCHED __builtin_amdgcn_sched_barrier(0)
    Unit cur, nxt; int ui = 0;
    if (!S.next(0, cur)) return;
    f32x4 acc[2][2][4][2];
#pragma unroll
    for (int a = 0; a < 2; ++a)
#pragma unroll
        for (int b = 0; b < 2; ++b)
#pragma unroll
            for (int m = 0; m < 4; ++m)
#pragma unroll
                for (int n = 0; n < 2; ++n) acc[a][b][m][n] = (f32x4){0.f, 0.f, 0.f, 0.f};
    bf16x8 At[4][2], B0[2][2], B1[2][2];
    const char* cA = PG8_UA(cur); const char* cB = PG8_UB(cur);
    PG8_STAGE(PG8_SB(0, 0), cB, voffB); PG8_STAGE(PG8_SB(0, 1), cB + hB, voffB); PG8_STAGE(PG8_SA(0, 0), cA, voffA); PG8_STAGE(PG8_SA(0, 1), cA + hA, voffA);
    if (wr == 1) PG8_BAR;
    PG8_WAIT_V(2); PG8_BAR;
    PG8_STAGE(PG8_SB(1, 0), cB + kstep, voffB); PG8_STAGE(PG8_SA(1, 0), cA + kstep, voffA); PG8_STAGE(PG8_SB(1, 1), cB + hB + kstep, voffB);
    PG8_WAIT_V(6); PG8_BAR;
    for (;;) {
        const bool has_next = S.next(ui + 1, nxt);
        const char* nA = has_next ? PG8_UA(nxt) : cA; const char* nB = has_next ? PG8_UB(nxt) : cB;
        for (int t = 0; t < nt; t += 2) {
            const bool last = (t == nt - 2);
            const char* a1 = cA + (size_t)(t + 1) * kstep;
            const char* a2 = last ? nA : cA + (size_t)(t + 2) * kstep; const char* b2 = last ? nB : cB + (size_t)(t + 2) * kstep;
            const char* a3 = a2 + kstep; const char* b3 = b2 + kstep;
            PG8_LDB(B0, 0, 0); PG8_LDB(B1, 0, 1); PG8_SCHED; PG8_LDA(At, 0, 0); PG8_STAGE(PG8_SA(1, 1), a1 + hA, voffA);
            PG8_WAIT_V(8); PG8_WAIT_L(0); PG8_BAR; PG8_MMA(0, 0, At, B0); PG8_MMA(0, 1, At, B1); PG8_BAR; PG8_SCHED;
            PG8_LDA(At, 0, 1); PG8_STAGE(PG8_SB(0, 0), b2, voffB); PG8_STAGE(PG8_SB(0, 1), b2 + hB, voffB); PG8_STAGE(PG8_SA(0, 0), a2, voffA);
            PG8_WAIT_V(8); PG8_WAIT_L(0); PG8_BAR; PG8_MMA(1, 0, At, B0); PG8_MMA(1, 1, At, B1); PG8_BAR; PG8_SCHED;
            PG8_LDB(B0, 1, 0); PG8_LDB(B1, 1, 1); PG8_SCHED; PG8_LDA(At, 1, 0); PG8_STAGE(PG8_SA(0, 1), a2 + hA, voffA);
            PG8_WAIT_V(8); PG8_WAIT_L(0); PG8_BAR; PG8_MMA(0, 0, At, B0); PG8_MMA(0, 1, At, B1); PG8_BAR; PG8_SCHED;
            PG8_LDA(At, 1, 1); PG8_STAGE(PG8_SB(1, 0), b3, voffB); PG8_STAGE(PG8_SB(1, 1), b3 + hB, voffB); PG8_STAGE(PG8_SA(1, 0), a3, voffA);
            PG8_WAIT_V(8); PG8_WAIT_L(0); PG8_BAR; PG8_MMA(1, 0, At, B0); PG8_MMA(1, 1, At, B1); PG8_BAR; PG8_SCHED;
        }
        if constexpr (ALIGN_EPI) { if (wr == 0) PG8_BAR; }
        if constexpr (!Epi::AFTER_DRAIN) { E(acc, cur, wr, wc, fr, fq); }
        if (!has_next) break;
#pragma unroll
        for (int a = 0; a < 2; ++a)
#pragma unroll
            for (int b = 0; b < 2; ++b)
#pragma unroll
                for (int m = 0; m < 4; ++m)
#pragma unroll
                    for (int n = 0; n < 2; ++n) acc[a][b][m][n] = (f32x4){0.f, 0.f, 0.f, 0.f};
        cur = nxt; cA = nA; cB = nB; ++ui;
        if constexpr (ALIGN_EPI) { if (wr == 1) PG8_BAR; }
    }
    PG8_WAIT_V(0);
    if constexpr (!ALIGN_EPI) { if (wr == 0) PG8_BAR; }
    PG8_BAR;
    if constexpr (Epi::AFTER_DRAIN) { E.fused(acc, cur, wr, wc, fr, fq, lds, wid, lane); }
#undef PG8_UA
#undef PG8_UB
#undef PG8_SA
#undef PG8_SB
#undef PG8_STAGE
#undef PG8_LDA
#undef PG8_LDB
#undef PG8_MMA
#undef PG8_WAIT_V
#undef PG8_WAIT_L
#undef PG8_BAR
#undef PG8_SCHED
}
}
constexpr int NWAVES = 8, NTHR = NWAVES * 64;
constexpr int D = 1024, SEQ = 4096, BATCH = 4, M = BATCH * SEQ;
constexpr int CHUNK = 64, NCH = SEQ / CHUNK;
constexpr int GIN = 3088, NQKVG = 3072;
constexpr float EPS = 1e-6f;
constexpr int NPH = 11;

constexpr size_t MiB = 1u << 20;
constexpr size_t WS_CTL = 0, CTL_ZERO_BYTES = 1 * MiB;
constexpr size_t WS_W1T = 1 * MiB, WS_GWT = 5 * MiB, WS_W3T = 6 * MiB, WS_W4T = 8 * MiB, WS_W6T = 15 * MiB;
constexpr size_t WS_RSTD0 = 17 * MiB, WS_SSQ1 = 17 * MiB + 64 * 1024, WS_SSQ2 = 17 * MiB + 320 * 1024;
constexpr size_t WS_GKL = 18 * MiB, WS_DECAY = 19 * MiB, WS_SSQO = 20 * MiB;
constexpr size_t WS_XB = 24 * MiB, WS_US = 56 * MiB, WS_QKVG = 24 * MiB;
constexpr size_t WS_POOLED = 120 * MiB, WS_QP = 120 * MiB, WS_KDT = 136 * MiB;
constexpr size_t WS_Y = 152 * MiB, WS_SC = 152 * MiB, WS_Y2 = 152 * MiB;
constexpr size_t WS_H1B = 184 * MiB, WS_O = 184 * MiB;
constexpr size_t WS_DBG = 216 * MiB, WS_END = 256 * MiB;
constexpr int CW_BAR = 4096, N_BAR_REGIONS = 12;

constexpr int RING_BYTES = 131072, LDSCTL_OFF = RING_BYTES, MISC_OFF = LDSCTL_OFF + 320, LDS_BYTES = 147456;

#define GAS __attribute__((address_space(1)))
#define LAS __attribute__((address_space(3)))
typedef unsigned short bf16;
typedef unsigned v4u __attribute__((ext_vector_type(4)));
typedef unsigned v2u __attribute__((ext_vector_type(2)));
typedef float f32x4 __attribute__((ext_vector_type(4)));
typedef short bf16x8 __attribute__((ext_vector_type(8)));
typedef GAS unsigned gu32;
#define RLX_AGENT __ATOMIC_RELAXED, __HIP_MEMORY_SCOPE_AGENT
#define LDS_WAIT() asm volatile("s_waitcnt lgkmcnt(0)" ::: "memory")
#define VM_WAIT() asm volatile("s_waitcnt vmcnt(0)" ::: "memory")
__device__ __forceinline__ unsigned f2bf(float f) { unsigned u = __builtin_bit_cast(unsigned, f); return (u + 0x7fffu + ((u >> 16) & 1u)) >> 16; }
__device__ __forceinline__ unsigned pk2(float lo, float hi) { return f2bf(lo) | (f2bf(hi) << 16); }
__device__ __forceinline__ float bf2f(unsigned h) { return __builtin_bit_cast(float, h << 16); }
__device__ __forceinline__ float bflo(unsigned w) { return __builtin_bit_cast(float, w << 16); }
__device__ __forceinline__ float bfhi(unsigned w) { return __builtin_bit_cast(float, w & 0xffff0000u); }
__device__ __forceinline__ float fsilu(float v) { return v * __builtin_amdgcn_rcpf(1.f + __builtin_amdgcn_exp2f(-1.4426950408889634f * v)); }
__device__ __forceinline__ float wave_sum(float v) {
#pragma unroll
    for (int o = 1; o < 64; o <<= 1) v += __shfl_xor(v, o);
    return v;
}

#define XB_TMO      128
#define XB_XCNT(j)  (256  + 64 * (j))
#define XB_XSUB(j)  (1280 + 64 * (j))
#define XB_XGEN(j)  (2304 + 64 * (j))
#define XB_TOP      3328
#define XB_TOPGEN   3392
#define XCD_BAR_WORDS 3456
#define XB_SPIN_CAP (1u << 18)
__device__ __forceinline__ unsigned xb_ld(unsigned* p)              { return __hip_atomic_load(p, __ATOMIC_RELAXED, __HIP_MEMORY_SCOPE_AGENT); }
__device__ __forceinline__ unsigned xb_add(unsigned* p, unsigned v) { return __hip_atomic_fetch_add(p, v, __ATOMIC_RELAXED, __HIP_MEMORY_SCOPE_AGENT); }
__device__ __forceinline__ unsigned xb_xcc_id() { return (unsigned)__builtin_amdgcn_s_getreg((3 << 11) | 20) & 0xFu; }
#define XB_SPIN(cond, bar) do { unsigned _sp = 0; while (cond) { __builtin_amdgcn_s_sleep(1); \
    if ((++_sp & 255u) == 0u) { if (xb_ld(&(bar)[XB_TMO])) break; if (_sp > XB_SPIN_CAP) { atomicAdd(&(bar)[XB_TMO], 1u); break; } } } } while (0)
struct XcdBarrier { unsigned* bar; unsigned x; volatile LAS unsigned* st; };
__device__ __forceinline__ XcdBarrier xcd_barrier_post(unsigned* bar, volatile LAS unsigned* st) {
    XcdBarrier b; b.bar = bar; b.x = xb_xcc_id(); b.st = st;
    if (threadIdx.x == 0) (void)xb_add(&bar[XB_XCNT(b.x)], 1u);
    return b;
}
__device__ __forceinline__ void xcd_barrier_complete(unsigned* bar, unsigned x, unsigned& nloc, unsigned& nx) {
    const unsigned G = gridDim.x * gridDim.y * gridDim.z;
    unsigned sum, cnt, mine, sp = 0u;
    for (;;) {
        sum = 0u; cnt = 0u; mine = 0u;
#pragma unroll
        for (unsigned j = 0; j < 16; ++j) { const unsigned c = xb_ld(&bar[XB_XCNT(j)]); sum += c; cnt += (c > 0u) ? 1u : 0u; mine = (j == x) ? c : mine; }
        if (sum == G) break;
        __builtin_amdgcn_s_sleep(1);
        if ((++sp & 255u) == 0u) { if (xb_ld(&bar[XB_TMO])) break; if (sp > XB_SPIN_CAP) { atomicAdd(&bar[XB_TMO], 1u); break; } }
    }
    nloc = mine > 0u ? mine : 1u; nx = cnt > 0u ? cnt : 1u;
}
__device__ __forceinline__ void xcd_barrier(const XcdBarrier& b) {
    asm volatile("s_waitcnt vmcnt(0)" ::: "memory");
    __syncthreads();
    if (threadIdx.x == 0) {
        unsigned* bar = b.bar;
        __builtin_amdgcn_s_waitcnt(0);
        unsigned nloc = b.st[0], nx = b.st[1];
        if (nloc == 0u) { xcd_barrier_complete(bar, b.x, nloc, nx); b.st[0] = nloc; b.st[1] = nx; }
        const unsigned old = xb_add(&bar[XB_XSUB(b.x)], 1u);
        const unsigned gen = old / nloc;
        if (old + 1u == (gen + 1u) * nloc) {
            __builtin_amdgcn_fence(__ATOMIC_RELEASE, "agent");
            asm volatile("s_waitcnt vmcnt(0)" ::: "memory");
            const unsigned og = xb_add(&bar[XB_TOP], 1u);
            const unsigned tg = og / nx;
            if (og + 1u == (tg + 1u) * nx) xb_add(&bar[XB_TOPGEN], 1u);
            else XB_SPIN(xb_ld(&bar[XB_TOPGEN]) == tg, bar);
            __builtin_amdgcn_fence(__ATOMIC_ACQUIRE, "agent");
            xb_add(&bar[XB_XGEN(b.x)], 1u);
            asm volatile("s_waitcnt vmcnt(0)" ::: "memory");
        } else {
            XB_SPIN(xb_ld(&bar[XB_XGEN(b.x)]) == gen, bar);
            __builtin_amdgcn_fence(__ATOMIC_ACQUIRE, "agent");
            asm volatile("s_waitcnt vmcnt(0)" ::: "memory");
        }
    }
    __syncthreads();
}

struct Frame {
    LAS unsigned char* lds;
    int tid, lane, wave, vcu, G;
    unsigned char* ws;
    const float* in[13];
    float* out;
};
using pg8::Unit;
struct Epi1 {
    static constexpr bool PERM = true, AFTER_DRAIN = false;
    bf16* US; const float* rstd0;
    __device__ __forceinline__ void operator()(const f32x4 (&acc)[2][2][4][2], const Unit& u, int wr, int wc, int fr, int fq) const {
        const int row0 = u.pm * 256 + wr * 64 + fr, col0 = u.pn * 256 + wc * 32 + 8 * fq; const bool gate = u.pn >= 4;
#pragma unroll
        for (int ai = 0; ai < 2; ++ai)
#pragma unroll
            for (int m = 0; m < 4; ++m) { const int row = row0 + ai * 128 + m * 16; const float rs = rstd0[row]; bf16* rowp = US + (size_t)row * 2048 + col0;
#pragma unroll
                for (int bj = 0; bj < 2; ++bj) { f32x4 v0 = acc[ai][bj][m][0] * rs, v1 = acc[ai][bj][m][1] * rs;
                    if (gate) {
#pragma unroll
                        for (int e = 0; e < 4; ++e) { v0[e] = fsilu(v0[e]); v1[e] = fsilu(v1[e]); } }
                    v4u w; w.x = pg8::cvt_pk_bf16(v0[0], v0[1]); w.y = pg8::cvt_pk_bf16(v0[2], v0[3]); w.z = pg8::cvt_pk_bf16(v1[0], v1[1]); w.w = pg8::cvt_pk_bf16(v1[2], v1[3]);
                    *(v4u*)(rowp + bj * 128) = w; } }
    }
};
struct Epi2 {
    static constexpr bool PERM = true, AFTER_DRAIN = false;
    bf16* Y; const bf16* US; const float* gb; const float* sc;
    __device__ __forceinline__ void operator()(const f32x4 (&acc)[2][2][4][2], const Unit& u, int wr, int wc, int fr, int fq) const {
        const int row0 = u.pm * 256 + wr * 64 + fr, col0 = u.pn * 256 + wc * 32 + 8 * fq;
        f32x4 bv[2][2], sv[2][2];
#pragma unroll
        for (int bj = 0; bj < 2; ++bj)
#pragma unroll
            for (int n = 0; n < 2; ++n) { bv[bj][n] = *(const f32x4*)(gb + col0 + bj * 128 + 4 * n); sv[bj][n] = *(const f32x4*)(sc + col0 + bj * 128 + 4 * n); }
#pragma unroll
        for (int ai = 0; ai < 2; ++ai)
#pragma unroll
            for (int m = 0; m < 4; ++m) { const int row = row0 + ai * 128 + m * 16;
#pragma unroll
                for (int bj = 0; bj < 2; ++bj) { const v4u g = *(const v4u*)(US + (size_t)row * 2048 + 1024 + col0 + bj * 128);
                    f32x4 v0 = (acc[ai][bj][m][0] + bv[bj][0]) * sv[bj][0], v1 = (acc[ai][bj][m][1] + bv[bj][1]) * sv[bj][1];
                    v0[0] *= bflo(g.x); v0[1] *= bfhi(g.x); v0[2] *= bflo(g.y); v0[3] *= bfhi(g.y); v1[0] *= bflo(g.z); v1[1] *= bfhi(g.z); v1[2] *= bflo(g.w); v1[3] *= bfhi(g.w);
                    v4u w; w.x = pg8::cvt_pk_bf16(v0[0], v0[1]); w.y = pg8::cvt_pk_bf16(v0[2], v0[3]); w.z = pg8::cvt_pk_bf16(v1[0], v1[1]); w.w = pg8::cvt_pk_bf16(v1[2], v1[3]);
                    *(v4u*)(Y + (size_t)row * 1024 + col0 + bj * 128) = w; } }
    }
};
template <bool WB> struct EpiRes {
    static constexpr bool PERM = false, AFTER_DRAIN = true;
    const float* base; float* out; bf16* hb; float* ssq;
    __device__ __forceinline__ void fused(f32x4 (&acc)[2][2][4][2], const Unit& u, int wr, int wc, int fr, int fq, PG8_LAS unsigned char* lds, int wid, int lane) const {
        PG8_LAS float* P = (PG8_LAS float*)lds;
        const int col0 = u.pn * 256 + wc * 32 + 4 * fq;
#pragma unroll
        for (int ai = 0; ai < 2; ++ai)
#pragma unroll
            for (int m = 0; m < 4; ++m) { const int rl = ai * 128 + wr * 64 + m * 16 + fr; const size_t off = (size_t)(u.pm * 256 + rl) * 1024 + col0; float s = 0.f;
#pragma unroll
                for (int bj = 0; bj < 2; ++bj)
#pragma unroll
                    for (int n = 0; n < 2; ++n) { const f32x4 h = *(const f32x4*)(base + off + bj * 128 + n * 16) + acc[ai][bj][m][n];
                        *(f32x4*)(out + off + bj * 128 + n * 16) = h;
                        if (WB) { v2u w; w.x = pg8::cvt_pk_bf16(h[0], h[1]); w.y = pg8::cvt_pk_bf16(h[2], h[3]); *(v2u*)(hb + off + bj * 128 + n * 16) = w; }
                        s += (h[0] * h[0] + h[1] * h[1]) + (h[2] * h[2] + h[3] * h[3]); }
                s += __shfl_xor(s, 16); s += __shfl_xor(s, 32);
                if (fq == 0) P[rl * 4 + wc] = s; }
        asm volatile("s_waitcnt lgkmcnt(0)" ::: "memory"); __builtin_amdgcn_s_barrier(); asm volatile("" ::: "memory");
        const int tid = wid * 64 + lane;
        if (tid < 256) { const float s = (P[tid * 4 + 0] + P[tid * 4 + 1]) + (P[tid * 4 + 2] + P[tid * 4 + 3]); ssq[(size_t)u.pn * M + u.pm * 256 + tid] = s; }
        asm volatile("s_waitcnt lgkmcnt(0)" ::: "memory"); __builtin_amdgcn_s_barrier(); asm volatile("" ::: "memory");
    }
};
__device__ __forceinline__ float rstd_from4(const float* ssq, int row) {
    const float s = (ssq[row] + ssq[M + row]) + (ssq[2 * M + row] + ssq[3 * M + row]);
    return __builtin_amdgcn_rsqf(s * (1.f / 1024.f) + EPS);
}
struct Epi4 {
    static constexpr bool PERM = true, AFTER_DRAIN = false;
    bf16* O; const float* ssq1;
    __device__ __forceinline__ void operator()(const f32x4 (&acc)[2][2][4][2], const Unit& u, int wr, int wc, int fr, int fq) const {
        const int row0 = u.pm * 256 + wr * 64 + fr, col0 = u.pn * 256 + wc * 32 + 8 * fq; const bool gate = u.pn >= 8; const float qs = u.pn < 2 ? 0.08838834764831845f : 1.f;
#pragma unroll
        for (int ai = 0; ai < 2; ++ai)
#pragma unroll
            for (int m = 0; m < 4; ++m) { const int row = row0 + ai * 128 + m * 16; const float rs = rstd_from4(ssq1, row) * qs; bf16* rowp = O + (size_t)row * NQKVG + col0;
#pragma unroll
                for (int bj = 0; bj < 2; ++bj) { f32x4 v0 = acc[ai][bj][m][0] * rs, v1 = acc[ai][bj][m][1] * rs;
                    if (gate) {
#pragma unroll
                        for (int e = 0; e < 4; ++e) { v0[e] = fsilu(v0[e]); v1[e] = fsilu(v1[e]); } }
                    v4u w; w.x = pg8::cvt_pk_bf16(v0[0], v0[1]); w.y = pg8::cvt_pk_bf16(v0[2], v0[3]); w.z = pg8::cvt_pk_bf16(v1[0], v1[1]); w.w = pg8::cvt_pk_bf16(v1[2], v1[3]);
                    *(v4u*)(rowp + bj * 128) = w; } }
    }
};

#define PHASE_IDS() int tid_ = F.tid; asm volatile("" : "+v"(tid_)); const int tid = tid_, lane = tid & 63; (void)lane
__device__ __forceinline__ void p0_transpose_item(const float* W, int K, int N, const float* ks, bf16* WT, LAS float* scr, int item, int lane) {
    const int nblk = (N + 31) / 32, kb = item / nblk, nb = item % nblk, k0 = 64 * kb, n0 = 32 * nb;
    const int n_in = n0 + (lane & 31);
#pragma unroll 8
    for (int i = 0; i < 32; ++i) { const int kk = 2 * i + (lane >> 5); float v = (n_in < N) ? W[(size_t)(k0 + kk) * N + n_in] : 0.f; if (ks) v *= ks[k0 + kk]; scr[kk * 33 + (lane & 31)] = v; }
    LDS_WAIT(); asm volatile("" ::: "memory");
    const int c = lane & 7;
#pragma unroll
    for (int j = 0; j < 4; ++j) { const int n = (lane >> 3) + 8 * j; const LAS float* s = scr + (8 * c) * 33 + n;
        v4u o; o.x = pk2(s[0 * 33], s[1 * 33]); o.y = pk2(s[2 * 33], s[3 * 33]); o.z = pk2(s[4 * 33], s[5 * 33]); o.w = pk2(s[6 * 33], s[7 * 33]);
        *(GAS v4u*)(WT + (size_t)(n0 + n) * K + k0 + 8 * c) = o; }
    LDS_WAIT(); asm volatile("" ::: "memory");
}
__device__ __forceinline__ void phase_prep(Frame& F) {
    PHASE_IDS();
    LAS float* scr = (LAS float*)(F.lds + F.wave * 16384);
    const int gw = F.vcu * NWAVES + F.wave, NGW = F.G * NWAVES;
    constexpr int I1 = 16 * 64, IG = 4 * 8, I3 = 16 * 32, I4 = 16 * 97, I6 = 16 * 32;
    constexpr int NITEMS = I1 + 4 * IG + I3 + I4 + I6;
    const float* nw = F.in[1];
    for (int it = gw; it < NITEMS; it += NGW) {
        int r = it;
        if (r < I1) { p0_transpose_item(F.in[2], 1024, 2048, nw, (bf16*)(F.ws + WS_W1T), scr, r, lane); continue; } r -= I1;
        if (r < 4 * IG) { const int g = r / IG; p0_transpose_item(F.in[3] + (size_t)g * 65536, 256, 256, nullptr, (bf16*)(F.ws + WS_GWT) + (size_t)g * 65536, scr, r % IG, lane); continue; } r -= 4 * IG;
        if (r < I3) { p0_transpose_item(F.in[6], 1024, 1024, nullptr, (bf16*)(F.ws + WS_W3T), scr, r, lane); continue; } r -= I3;
        if (r < I4) { p0_transpose_item(F.in[7], 1024, GIN, nw + 1024, (bf16*)(F.ws + WS_W4T), scr, r, lane); continue; } r -= I4;
        p0_transpose_item(F.in[11], 1024, 1024, nullptr, (bf16*)(F.ws + WS_W6T), scr, r, lane);
    }
    const float* x = F.in[0]; bf16* XB = (bf16*)(F.ws + WS_XB); float* rstd0 = (float*)(F.ws + WS_RSTD0);
    for (int m = gw; m < M; m += NGW) {
        const GAS f32x4* xr = (const GAS f32x4*)(x + (size_t)m * D) + lane;
        f32x4 v[4]; float s = 0.f;
#pragma unroll
        for (int j = 0; j < 4; ++j) { v[j] = xr[64 * j]; s += (v[j].x * v[j].x + v[j].y * v[j].y) + (v[j].z * v[j].z + v[j].w * v[j].w); }
        s = wave_sum(s);
        if (lane == 0) rstd0[m] = __builtin_amdgcn_rsqf(s * (1.f / D) + EPS);
        GAS v2u* o8 = (GAS v2u*)(XB + (size_t)m * D) + lane;
#pragma unroll
        for (int j = 0; j < 4; ++j) { v2u w; w.x = pk2(v[j].x, v[j].y); w.y = pk2(v[j].z, v[j].w); o8[64 * j] = w; }
    }
}
__device__ __forceinline__ void unpack8(const v4u w, float (&f)[8]) { f[0] = bflo(w.x); f[1] = bfhi(w.x); f[2] = bflo(w.y); f[3] = bfhi(w.y); f[4] = bflo(w.z); f[5] = bfhi(w.z); f[6] = bflo(w.w); f[7] = bfhi(w.w); }
__device__ __forceinline__ void phase_pool(Frame& F) {
    PHASE_IDS();
    const bf16* US = (const bf16*)(F.ws + WS_US); bf16* PO = (bf16*)(F.ws + WS_POOLED);
    for (int gid = F.vcu * NTHR + tid; gid < 1024 * 128; gid += F.G * NTHR) {
        const int c8 = gid & 127, run = gid >> 7, t0 = run * 16, pos0 = t0 & (SEQ - 1), w = 2 << (c8 >> 5);
        const bf16* up = US + (size_t)t0 * 2048 + c8 * 8;
        float s[8], f[8];
#pragma unroll
        for (int e = 0; e < 8; ++e) s[e] = 0.f;
        if (pos0 > 0) for (int i = 1; i < w; ++i) { unpack8(*(const v4u*)(up - (size_t)i * 2048), f);
#pragma unroll
            for (int e = 0; e < 8; ++e) s[e] += f[e]; }
#pragma unroll 4
        for (int j = 0; j < 16; ++j) {
            unpack8(*(const v4u*)(up + (size_t)j * 2048), f);
            const int p1 = pos0 + j + 1; const float inv = 1.f / (float)(p1 < w ? p1 : w);
#pragma unroll
            for (int e = 0; e < 8; ++e) s[e] += f[e];
            v4u o; o.x = pk2(s[0] * inv - f[0], s[1] * inv - f[1]); o.y = pk2(s[2] * inv - f[2], s[3] * inv - f[3]); o.z = pk2(s[4] * inv - f[4], s[5] * inv - f[5]); o.w = pk2(s[6] * inv - f[6], s[7] * inv - f[7]);
            *(v4u*)(PO + (size_t)(t0 + j) * 1024 + c8 * 8) = o;
            if (p1 >= w) { unpack8(*(const v4u*)(up + (ptrdiff_t)(j + 1 - w) * 2048), f);
#pragma unroll
                for (int e = 0; e < 8; ++e) s[e] -= f[e]; }
        }
    }
}
__device__ __forceinline__ void phase_gklow(Frame& F) {
    PHASE_IDS();
    const bf16* H1B = (const bf16*)(F.ws + WS_H1B); const bf16* W4T = (const bf16*)(F.ws + WS_W4T); const float* ssq1 = (const float*)(F.ws + WS_SSQ1); float* GKL = (float*)(F.ws + WS_GKL);
    if (F.wave < 4) for (int item = F.vcu; item < M / 64; item += F.G) {
        const int r0 = item * 64 + F.wave * 16, l15 = lane & 15, lq = lane >> 4;
        const bf16* ap = H1B + (size_t)(r0 + l15) * 1024 + lq * 8; const bf16* bp = W4T + (size_t)(3072 + l15) * 1024 + lq * 8;
        f32x4 acc = (f32x4){0.f, 0.f, 0.f, 0.f};
#pragma unroll 8
        for (int kk = 0; kk < 32; ++kk) { const bf16x8 a = *(const bf16x8*)(ap + kk * 32), b = *(const bf16x8*)(bp + kk * 32); acc = __builtin_amdgcn_mfma_f32_16x16x32_bf16(a, b, acc, 0, 0, 0); }
#pragma unroll
        for (int r = 0; r < 4; ++r) { const int row = r0 + 4 * lq + r; GKL[(size_t)row * 16 + l15] = acc[r] * rstd_from4(ssq1, row); }
    }
}
constexpr int A_QPS = 0, A_QNS = 17408, A_KPS = 34816, A_KNS = 52224, A_GLS = 69632, A_TOT = 73728, A_ROW = 272;
__device__ __forceinline__ void p5a_item(Frame& F, int item) {
    PHASE_IDS();
    const bf16* QKVG = (const bf16*)(F.ws + WS_QKVG); const float* GKL = (const float*)(F.ws + WS_GKL);
    bf16* QP = (bf16*)(F.ws + WS_QP); bf16* KDT = (bf16*)(F.ws + WS_KDT); bf16* SC = (bf16*)(F.ws + WS_SC); float* DECAY = (float*)(F.ws + WS_DECAY);
    const float* gkw = F.in[8]; const float* gkb = F.in[9];
    LAS unsigned char* lds = F.lds;
    const int h = item & 3, bn = item >> 2, t0 = bn * 64;
    if (tid < 256) ((LAS f32x4*)(lds + A_GLS))[tid] = ((const f32x4*)(GKL + (size_t)t0 * 16))[tid];
    const int k = tid & 127, tg = tid >> 7;
    float w[16];
#pragma unroll
    for (int r = 0; r < 16; ++r) w[r] = gkw[r * 512 + h * 128 + k];
    const float bb = gkb[h * 128 + k];
    unsigned short qv[16], kv[16];
    { const bf16* qb = QKVG + (size_t)(t0 + tg * 16) * NQKVG + h * 128 + k;
#pragma unroll
      for (int j = 0; j < 16; ++j) { qv[j] = qb[(size_t)j * NQKVG]; kv[j] = qb[(size_t)j * NQKVG + 512]; } }
    __syncthreads();
    float c[16]; float run = 0.f;
#pragma unroll
    for (int j = 0; j < 16; ++j) { const LAS float* g = (const LAS float*)(lds + A_GLS) + (tg * 16 + j) * 16; float z = bb;
#pragma unroll
        for (int r = 0; r < 16; ++r) z += g[r] * w[r];
        const float ls = fminf(z, 0.f) - __logf(1.f + __expf(-fabsf(z)));
        run += ls * (1.f / 16.f); c[j] = run; }
    ((LAS float*)(lds + A_TOT))[tg * 128 + k] = run;
    __syncthreads();
    float pre = 0.f, cl = 0.f;
#pragma unroll
    for (int g = 0; g < 4; ++g) { const float tt = ((const LAS float*)(lds + A_TOT))[g * 128 + k]; pre += (g < tg) ? tt : 0.f; cl += tt; }
    unsigned kdp[8];
#pragma unroll
    for (int j = 0; j < 16; ++j) { const int t = tg * 16 + j; const float cum = pre + c[j];
        const float ep = __expf(cum), en = __expf(-cum), ed = __expf(cl - cum), q = bf2f(qv[j]), kk = bf2f(kv[j]);
        const unsigned qp = f2bf(q * ep);
        *(LAS unsigned short*)(lds + A_QPS + t * A_ROW + k * 2) = (unsigned short)qp;
        *(LAS unsigned short*)(lds + A_QNS + t * A_ROW + k * 2) = (unsigned short)f2bf(q * en);
        *(LAS unsigned short*)(lds + A_KPS + t * A_ROW + k * 2) = (unsigned short)f2bf(kk * ep);
        *(LAS unsigned short*)(lds + A_KNS + t * A_ROW + k * 2) = (unsigned short)f2bf(kk * en);
        QP[(size_t)(t0 + t) * 512 + h * 128 + k] = (bf16)qp;
        const unsigned kd = f2bf(kk * ed);
        if (j & 1) kdp[j >> 1] |= kd << 16; else kdp[j >> 1] = kd; }
    { v4u* dst = (v4u*)(KDT + (size_t)item * 8192 + k * 64 + tg * 16);
      dst[0] = (v4u){kdp[0], kdp[1], kdp[2], kdp[3]}; dst[1] = (v4u){kdp[4], kdp[5], kdp[6], kdp[7]}; }
    if (tg == 0) DECAY[(size_t)bn * 512 + h * 128 + k] = __expf(cl);
    __syncthreads();
    const int l15 = lane & 15, lq = lane >> 4;
#pragma unroll
    for (int e = 0; e < 2; ++e) { const int idx = F.wave * 2 + e, ti = idx >> 2, si = idx & 3;
        f32x4 af = (f32x4){0.f, 0.f, 0.f, 0.f}, ab = (f32x4){0.f, 0.f, 0.f, 0.f};
        const int ao = (si * 16 + l15) * A_ROW + lq * 16, bo = (ti * 16 + l15) * A_ROW + lq * 16;
        if (ti >= si) {
#pragma unroll
            for (int kk = 0; kk < 4; ++kk) af = __builtin_amdgcn_mfma_f32_16x16x32_bf16(*(const LAS bf16x8*)(lds + A_KNS + ao + kk * 64), *(const LAS bf16x8*)(lds + A_QPS + bo + kk * 64), af, 0, 0, 0); }
        if (ti <= si) {
#pragma unroll
            for (int kk = 0; kk < 4; ++kk) ab = __builtin_amdgcn_mfma_f32_16x16x32_bf16(*(const LAS bf16x8*)(lds + A_KPS + ao + kk * 64), *(const LAS bf16x8*)(lds + A_QNS + bo + kk * 64), ab, 0, 0, 0); }
        const int t = ti * 16 + l15; float v[4];
#pragma unroll
        for (int r = 0; r < 4; ++r) { const int s = si * 16 + 4 * lq + r; v[r] = (s <= t) ? af[r] : ab[r]; }
        v2u o; o.x = pk2(v[0], v[1]); o.y = pk2(v[2], v[3]);
        *(v2u*)(SC + (size_t)item * 4096 + t * 64 + si * 16 + 4 * lq) = o; }
    __syncthreads();
}
__device__ __forceinline__ void phase_gla_prep(Frame& F) { for (int item = F.vcu; item < BATCH * NCH * 4; item += F.G) p5a_item(F, item); }

struct ORegs { bf16x8 sc[2], qp[4], bv[2]; };
struct SRegs { bf16x8 kd[2][2], bv[2]; f32x4 d[2]; };
__device__ __forceinline__ void load_bv(bf16x8 (&bv)[2], const bf16* vp  , int lq) {
#pragma unroll
    for (int ks = 0; ks < 2; ++ks) { unsigned short e[8];
#pragma unroll
        for (int j = 0; j < 8; ++j) e[j] = vp[(size_t)(32 * ks + 8 * lq + j) * NQKVG];
        v4u w; w.x = e[0] | ((unsigned)e[1] << 16); w.y = e[2] | ((unsigned)e[3] << 16); w.z = e[4] | ((unsigned)e[5] << 16); w.w = e[6] | ((unsigned)e[7] << 16);
        bv[ks] = __builtin_bit_cast(bf16x8, w); }
}
__device__ __forceinline__ void phase_gla_scan(Frame& F) {
    PHASE_IDS();
    const bf16* QKVG = (const bf16*)(F.ws + WS_QKVG); const bf16* QP = (const bf16*)(F.ws + WS_QP); const bf16* KDT = (const bf16*)(F.ws + WS_KDT); const bf16* SC = (const bf16*)(F.ws + WS_SC);
    const float* DECAY = (const float*)(F.ws + WS_DECAY); bf16* O = (bf16*)(F.ws + WS_O); float* SSQO = (float*)(F.ws + WS_SSQO);
    LAS unsigned char* lds = F.lds;
    constexpr int SBB = 16 * 272;
    for (int unit = F.vcu; unit < 256; unit += F.G) {
        const int bh = unit >> 4, vs = unit & 15, b = bh >> 2, h = bh & 3;
        const int l15 = lane & 15, lq = lane >> 4, wave = F.wave;
        __syncthreads();
        for (int i = tid; i < 2 * SBB / 4; i += NTHR) ((LAS unsigned*)lds)[i] = 0u;
        __syncthreads();
        const bf16* vbase = QKVG + 1024 + h * 256 + vs * 16 + l15;
        if (wave < 4) {
            ORegs r0, r1;
#define LOAD_O(R, n) do { const int bn_ = b * 64 + (n); const size_t t0_ = (size_t)bn_ * 64; const size_t it_ = (size_t)bn_ * 4 + h; \
            _Pragma("unroll") for (int ks = 0; ks < 2; ++ks) (R).sc[ks] = *(const bf16x8*)(SC + it_ * 4096 + (wave * 16 + l15) * 64 + ks * 32 + lq * 8); \
            _Pragma("unroll") for (int ks = 0; ks < 4; ++ks) (R).qp[ks] = *(const bf16x8*)(QP + (t0_ + wave * 16 + l15) * 512 + h * 128 + ks * 32 + lq * 8); \
            load_bv((R).bv, vbase + t0_ * NQKVG, lq); } while (0)
#define COMP_O(R, n, cur) do { f32x4 a_ = (f32x4){0.f, 0.f, 0.f, 0.f}; \
            a_ = __builtin_amdgcn_mfma_f32_16x16x32_bf16((R).bv[0], (R).sc[0], a_, 0, 0, 0); a_ = __builtin_amdgcn_mfma_f32_16x16x32_bf16((R).bv[1], (R).sc[1], a_, 0, 0, 0); \
            _Pragma("unroll") for (int ks = 0; ks < 4; ++ks) a_ = __builtin_amdgcn_mfma_f32_16x16x32_bf16(*(const LAS bf16x8*)(lds + (cur) * SBB + l15 * 272 + ks * 64 + lq * 16), (R).qp[ks], a_, 0, 0, 0); \
            const size_t row_ = (size_t)(b * 64 + (n)) * 64 + wave * 16 + l15; \
            v2u o_; o_.x = pk2(a_[0], a_[1]); o_.y = pk2(a_[2], a_[3]); *(v2u*)(O + row_ * 1024 + h * 256 + vs * 16 + 4 * lq) = o_; \
            float p_ = (a_[0] * a_[0] + a_[1] * a_[1]) + (a_[2] * a_[2] + a_[3] * a_[3]); p_ += __shfl_xor(p_, 16); p_ += __shfl_xor(p_, 32); \
            if (lq == 0) SSQO[row_ * 64 + h * 16 + vs] = p_; } while (0)
            LOAD_O(r0, 0);
            for (int n = 0; n < NCH; n += 2) {
                LOAD_O(r1, n + 1);
                COMP_O(r0, n, 0);
                __builtin_amdgcn_s_barrier();
                if (n + 2 < NCH) LOAD_O(r0, n + 2);
                COMP_O(r1, n + 1, 1);
                __builtin_amdgcn_s_barrier();
            }
#undef LOAD_O
#undef COMP_O
        } else {
            const int kb = (wave - 4) * 32;
            f32x4 S[2]; S[0] = (f32x4){0.f, 0.f, 0.f, 0.f}; S[1] = S[0];
            SRegs r0, r1;
#define LOAD_S(R, n) do { const int bn_ = b * 64 + (n); const size_t t0_ = (size_t)bn_ * 64; const size_t it_ = (size_t)bn_ * 4 + h; \
            _Pragma("unroll") for (int i = 0; i < 2; ++i) { _Pragma("unroll") for (int ks = 0; ks < 2; ++ks) (R).kd[i][ks] = *(const bf16x8*)(KDT + it_ * 8192 + (kb + 16 * i + l15) * 64 + ks * 32 + lq * 8); \
                (R).d[i] = *(const f32x4*)(DECAY + (size_t)bn_ * 512 + h * 128 + kb + 16 * i + 4 * lq); } \
            load_bv((R).bv, vbase + t0_ * NQKVG, lq); } while (0)
#define COMP_S(R, nxt) do { _Pragma("unroll") for (int i = 0; i < 2; ++i) { f32x4 a_ = S[i] * (R).d[i]; \
                a_ = __builtin_amdgcn_mfma_f32_16x16x32_bf16((R).kd[i][0], (R).bv[0], a_, 0, 0, 0); a_ = __builtin_amdgcn_mfma_f32_16x16x32_bf16((R).kd[i][1], (R).bv[1], a_, 0, 0, 0); S[i] = a_; \
                v2u o_; o_.x = pk2(a_[0], a_[1]); o_.y = pk2(a_[2], a_[3]); *(LAS v2u*)(lds + (nxt) * SBB + l15 * 272 + (kb + 16 * i + 4 * lq) * 2) = o_; } \
            asm volatile("s_waitcnt lgkmcnt(0)" ::: "memory"); } while (0)
            LOAD_S(r0, 0);
            for (int n = 0; n < NCH; n += 2) {
                LOAD_S(r1, n + 1);
                COMP_S(r0, 1);
                __builtin_amdgcn_s_barrier();
                if (n + 2 < NCH) LOAD_S(r0, n + 2);
                COMP_S(r1, 0);
                __builtin_amdgcn_s_barrier();
            }
#undef LOAD_S
#undef COMP_S
        }
    }
}
__device__ __forceinline__ void phase_headnorm(Frame& F) {
    PHASE_IDS();
    const bf16* O = (const bf16*)(F.ws + WS_O); const bf16* QKVG = (const bf16*)(F.ws + WS_QKVG); const float* SSQO = (const float*)(F.ws + WS_SSQO); bf16* Y2 = (bf16*)(F.ws + WS_Y2);
    const f32x4 hw = *((const f32x4*)F.in[10] + lane);
    const int gw = F.vcu * NWAVES + F.wave, NGW = F.G * NWAVES;
    for (int p = gw; p < M * 4; p += NGW) { const int t = p >> 2, h = p & 3;
        const v2u o = *((const v2u*)(O + (size_t)t * 1024 + h * 256) + lane);
        const v2u g = *((const v2u*)(QKVG + (size_t)t * NQKVG + 2048 + h * 256) + lane);
        float s = (lane < 16) ? SSQO[(size_t)t * 64 + h * 16 + lane] : 0.f;
        s = wave_sum(s);
        const float r = __builtin_amdgcn_rsqf(s * (1.f / 256.f) + EPS);
        v2u y; y.x = pk2(bflo(o.x) * r * hw.x * bflo(g.x), bfhi(o.x) * r * hw.y * bfhi(g.x)); y.y = pk2(bflo(o.y) * r * hw.z * bflo(g.y), bfhi(o.y) * r * hw.w * bfhi(g.y));
        *((v2u*)(Y2 + (size_t)t * 1024 + h * 256) + lane) = y; }
}
__device__ __forceinline__ void phase_final(Frame& F) {
    PHASE_IDS();
    const float* ssq2 = (const float*)(F.ws + WS_SSQ2); const float* fw = F.in[12];
    const int gw = F.vcu * NWAVES + F.wave, NGW = F.G * NWAVES;
    f32x4 wv[4];
#pragma unroll
    for (int j = 0; j < 4; ++j) wv[j] = *((const f32x4*)fw + lane + 64 * j);
    for (int m = gw; m < M; m += NGW) { const float r = rstd_from4(ssq2, m);
        GAS f32x4* xr = (GAS f32x4*)(F.out + (size_t)m * D) + lane;
#pragma unroll
        for (int j = 0; j < 4; ++j) { f32x4 v = xr[64 * j]; v = v * r * wv[j]; xr[64 * j] = v; } }
}
struct Args { const float* in[13]; float* out; unsigned char* ws; int ph_lo, ph_hi, li, pad; };
__global__ void __launch_bounds__(NTHR, 2) mk_fwd(Args args) {
    extern __shared__ __attribute__((aligned(16))) unsigned char lds_raw[];
    Frame F;
    F.lds = (LAS unsigned char*)lds_raw;
    F.tid = threadIdx.x; F.lane = F.tid & 63; F.wave = __builtin_amdgcn_readfirstlane(F.tid >> 6);
    F.G = gridDim.x; { const int bx = blockIdx.x; F.vcu = (F.G % 8 == 0) ? (bx % 8) * (F.G / 8) + bx / 8 : bx; }
    F.ws = args.ws; F.out = args.out;
#pragma unroll
    for (int i = 0; i < 13; ++i) F.in[i] = args.in[i];
    volatile LAS unsigned* MISC = (volatile LAS unsigned*)(F.lds + MISC_OFF);
    for (int u = F.tid; u < (LDS_BYTES - LDSCTL_OFF) / 4; u += NTHR) ((LAS unsigned*)(F.lds + LDSCTL_OFF))[u] = 0u;
    __syncthreads();
    unsigned* ctl = (unsigned*)(F.ws + WS_CTL);
    const int lo = args.ph_lo, hi = args.ph_hi;
    XcdBarrier bar; bar.bar = ctl + CW_BAR + args.li * XCD_BAR_WORDS; bar.x = 0; bar.st = nullptr;
    if (hi - lo > 1) bar = xcd_barrier_post(ctl + CW_BAR + args.li * XCD_BAR_WORDS, MISC + 8);
#define IN(k) (lo <= (k) && (k) < hi)
#define SEAM(k) do { if (IN(k) && IN((k) + 1)) xcd_barrier(bar); } while (0)
    unsigned char* ws = F.ws;
    if (IN(0)) { phase_prep(F); } SEAM(0);
    if (IN(1)) { pg8::Gemm g{(const bf16*)(ws + WS_XB), (const bf16*)(ws + WS_W1T), 1024, 1024, 1024, 0}; pg8::StaticOrder S; S.init(M, 2048, F.G, (int)blockIdx.x);
        Epi1 E{(bf16*)(ws + WS_US), (const float*)(ws + WS_RSTD0)}; pg8::gemm_phase<Epi1, true>(F.lds, g, S, E); } SEAM(1);
    if (IN(2)) { phase_pool(F); } SEAM(2);
    if (IN(3)) { pg8::Gemm g{(const bf16*)(ws + WS_POOLED), (const bf16*)(ws + WS_GWT), 1024, 256, 256, 256}; pg8::StaticOrder S; S.init(M, 1024, F.G, (int)blockIdx.x);
        Epi2 E{(bf16*)(ws + WS_Y), (const bf16*)(ws + WS_US), F.in[4], F.in[5]}; pg8::gemm_phase<Epi2, true>(F.lds, g, S, E); } SEAM(3);
    if (IN(4)) { pg8::Gemm g{(const bf16*)(ws + WS_Y), (const bf16*)(ws + WS_W3T), 1024, 1024, 1024, 0}; pg8::StaticOrder S; S.init(M, 1024, F.G, (int)blockIdx.x);
        EpiRes<true> E{F.in[0], F.out, (bf16*)(ws + WS_H1B), (float*)(ws + WS_SSQ1)}; pg8::gemm_phase<EpiRes<true>, false>(F.lds, g, S, E); } SEAM(4);
    if (IN(5)) { pg8::Gemm g{(const bf16*)(ws + WS_H1B), (const bf16*)(ws + WS_W4T), 1024, 1024, 1024, 0}; pg8::StaticOrder S; S.init(M, NQKVG, F.G, (int)blockIdx.x);
        Epi4 E{(bf16*)(ws + WS_QKVG), (const float*)(ws + WS_SSQ1)}; pg8::gemm_phase<Epi4, true>(F.lds, g, S, E);
        phase_gklow(F); } SEAM(5);
    if (IN(6)) { phase_gla_prep(F); } SEAM(6);
    if (IN(7)) { phase_gla_scan(F); } SEAM(7);
    if (IN(8)) { phase_headnorm(F); } SEAM(8);
    if (IN(9)) { pg8::Gemm g{(const bf16*)(ws + WS_Y2), (const bf16*)(ws + WS_W6T), 1024, 1024, 1024, 0}; pg8::StaticOrder S; S.init(M, 1024, F.G, (int)blockIdx.x);
        EpiRes<false> E{F.out, F.out, nullptr, (float*)(ws + WS_SSQ2)}; pg8::gemm_phase<EpiRes<false>, false>(F.lds, g, S, E); } SEAM(9);
    if (IN(10)) { phase_final(F); }
#undef IN
#undef SEAM
}
#if DBG
namespace dbg {
constexpr int ROWS = 512;
__global__ void __launch_bounds__(256) k_cmp(const void* fast, int is_bf16, int mode, long fs, long fo, const float* refp, long rs, long ro, int rows, int cols, int tr, unsigned* slots, int slot) {
    const long i = (long)blockIdx.x * 256 + threadIdx.x;
    float err = 0.f, mag = 0.f;
    if (i < (long)rows * cols) {
        const long r = i / cols, c = i % cols;
        long fi = r * fs + fo + c;
        if (mode == 1) { const long h = c >> 7, k = c & 127; fi = ((r >> 6) * 4 + h) * 8192 + k * 64 + (r & 63); }
        float a = is_bf16 ? __builtin_bit_cast(float, (unsigned)((const unsigned short*)fast)[fi] << 16) : ((const float*)fast)[fi];
        float b = refp[r * rs + ro + c];
        if (tr == 1) b = b / (1.f + __expf(-b)); else if (tr == 2) b *= 0.08838834764831845f;
        err = fabsf(a - b); mag = fabsf(b);
        if (!(err == err) || err > 3.0e38f) err = 3.0e38f;
    }
#pragma unroll
    for (int o = 1; o < 64; o <<= 1) { err = fmaxf(err, __shfl_xor(err, o)); mag = fmaxf(mag, __shfl_xor(mag, o)); }
    if ((threadIdx.x & 63) == 0) { atomicMax(slots + 2 * slot, __builtin_bit_cast(unsigned, err)); atomicMax(slots + 2 * slot + 1, __builtin_bit_cast(unsigned, mag)); }
}
__global__ void __launch_bounds__(256) k_encode(float* out, long n, const unsigned* slots, int nslots, int only_slot) {
    const long i = (long)blockIdx.x * 256 + threadIdx.x;
    if (i >= n) return;
    float v = 0.f;
    if (i == 0) {
        v = 990000.f;
        for (int s = 1; s < nslots; ++s) {
            const float err = __builtin_bit_cast(float, slots[2 * s]), mag = __builtin_bit_cast(float, slots[2 * s + 1]);
            const float rel = err / fmaxf(mag, 1e-20f);
            if (only_slot > 0) { if (s == only_slot) { v = rel * 1.0e6f + 1.0e4f; break; } continue; }
            int sev = 0;
            if (!(rel < 0.03f)) sev = rel < 0.1f ? 1 : rel < 0.3f ? 2 : rel < 1.f ? 3 : rel < 1e30f ? 4 : 5;
            if (mag == 0.f) sev = 6;
            if (sev) { v = (float)(10 * s + sev) * 1.0e4f; break; }
        }
    }
    out[i] = v;
}
}
#endif

extern "C" void kernel_launch(void* const* d_in, const int* in_sizes, int n_in, void* d_out, int out_size, void* d_ws, size_t ws_size, hipStream_t stream) {
    static int grid = 0;
    if (grid == 0) {
        if (n_in != 13 || in_sizes[0] != M * D || out_size != M * D || ws_size < WS_END) { fprintf(stderr, "kernel_launch: unexpected problem shape (n_in %d, in0 %d, out %d, ws %zu)\n", n_in, n_in > 0 ? in_sizes[0] : -1, out_size, ws_size); grid = -1; return; }
        int dev = 0, cus = 0, per_cu = 0;
        if (hipGetDevice(&dev) != hipSuccess || hipDeviceGetAttribute(&cus, hipDeviceAttributeMultiprocessorCount, dev) != hipSuccess) { grid = -1; return; }
        if (hipFuncSetAttribute((const void*)mk_fwd, hipFuncAttributeMaxDynamicSharedMemorySize, LDS_BYTES) != hipSuccess) { fprintf(stderr, "kernel_launch: hipFuncSetAttribute failed\n"); grid = -1; return; }
        if (hipOccupancyMaxActiveBlocksPerMultiprocessor(&per_cu, (const void*)mk_fwd, NTHR, LDS_BYTES) != hipSuccess || per_cu < 1) { fprintf(stderr, "kernel_launch: occupancy query says %d workgroups per CU\n", per_cu); (void)hipGetLastError(); grid = -1; return; }
        grid = cus;
    }
    if (grid < 0) return;
    (void)hipMemsetAsync((char*)d_ws + WS_CTL, 0, CTL_ZERO_BYTES, stream);
    Args a{};
    for (int i = 0; i < 13; ++i) a.in[i] = (const float*)d_in[i];
    a.out = (float*)d_out; a.ws = (unsigned char*)d_ws;
#if !DBG
    a.ph_lo = 0; a.ph_hi = NPH; a.li = 0;
    hipLaunchKernelGGL(mk_fwd, dim3(grid), dim3(NTHR), LDS_BYTES, stream, a);
#else
    unsigned char* ws = (unsigned char*)d_ws; hipStream_t st = stream;
    const int R = dbg::ROWS;
    float* rb = (float*)(ws + WS_DBG);
    size_t off = 0; auto take = [&](size_t nfl) { float* p = rb + off; off += (nfl + 63) & ~(size_t)63; return p; };
    float* P0 = take((size_t)R * 2048), *pooled = take((size_t)R * 1024), *y = take((size_t)R * 1024), *h1 = take((size_t)R * 1024), *proj = take((size_t)R * 3088), *cum = take((size_t)R * 512);
    float* qp = take((size_t)R * 512), *qn = take((size_t)R * 512), *kp = take((size_t)R * 512), *kn = take((size_t)R * 512), *kd = take((size_t)R * 512);
    float* scores = take((size_t)(R / 64) * 4 * 4096), *decay = take((size_t)(R / 64) * 512), *o = take((size_t)R * 1024), *y2 = take((size_t)R * 1024), *h2 = take((size_t)R * 1024), *outr = take((size_t)R * 1024), *rstd = take(R);
    {
        using namespace ref;
        const float* x = (const float*)d_in[0]; const float* norm_w = (const float*)d_in[1];
        auto gemm = [&](const float* A, int lda, const float* B, int ldb, float* C, int ldc, int Mr, int N, int K, const float* rs, const float* ks, const float* Rr, int ldr) {
            k_gemm<<<dim3((N + 63) / 64, Mr / 64), 256, 0, st>>>(A, lda, B, ldb, C, ldc, Mr, N, K, rs, ks, Rr, ldr); };
        k_rstd<<<R / 4, 256, 0, st>>>(x, rstd, R);
        gemm(x, 1024, (const float*)d_in[2], 2048, P0, 2048, R, 2048, 1024, rstd, norm_w, nullptr, 0);
        k_pool<<<(R * 1024) / 256, 256, 0, st>>>(P0, pooled, R);
        for (int g = 0; g < 4; ++g) gemm(pooled + g * 256, 1024, (const float*)d_in[3] + (size_t)g * 65536, 256, y + g * 256, 1024, R, 256, 256, nullptr, nullptr, nullptr, 0);
        k_gate0<<<(R * 1024) / 256, 256, 0, st>>>(y, P0, (const float*)d_in[4], (const float*)d_in[5], R);
        gemm(y, 1024, (const float*)d_in[6], 1024, h1, 1024, R, 1024, 1024, nullptr, nullptr, x, 1024);
        k_rstd<<<R / 4, 256, 0, st>>>(h1, rstd, R);
        gemm(h1, 1024, (const float*)d_in[7], 3088, proj, 3088, R, 3088, 1024, rstd, norm_w + 1024, nullptr, 0);
        k_cum<<<((R / 64) * 512) / 256, 256, 0, st>>>(proj, (const float*)d_in[8], (const float*)d_in[9], cum, R / 64);
        k_prep<<<(R * 512) / 256, 256, 0, st>>>(proj, cum, qp, qn, kp, kn, kd, decay, R);
        k_scores<<<(R / 64) * 4, 256, 0, st>>>(qp, qn, kp, kn, scores);
        k_gla_seq<<<64, 256, 0, st>>>(qp, kd, scores, decay, proj, o, R / 64);
        (void)hipMemcpyAsync(y2, o, (size_t)R * 1024 * 4, hipMemcpyDeviceToDevice, st);
        k_headnorm<<<R, 256, 0, st>>>(y2, proj, (const float*)d_in[10], R);
        gemm(y2, 1024, (const float*)d_in[11], 1024, h2, 1024, R, 1024, 1024, nullptr, nullptr, h1, 1024);
        (void)hipMemcpyAsync(outr, h2, (size_t)R * 1024 * 4, hipMemcpyDeviceToDevice, st);
        k_final<<<R / 4, 256, 0, st>>>(outr, (const float*)d_in[12], R);
    }
    unsigned* slots = (unsigned*)(ws + WS_CTL) + 2048;
    auto cmp = [&](const void* fast, int is_bf16, int mode, long fs, long fo, const float* refp, long rs, long ro, int rows, int cols, int tr, int slot) {
        dbg::k_cmp<<<(unsigned)(((long)rows * cols + 255) / 256), 256, 0, st>>>(fast, is_bf16, mode, fs, fo, refp, rs, ro, rows, cols, tr, slots, slot); };
    auto run = [&](int lo, int hi, int li) { a.ph_lo = lo; a.ph_hi = hi; a.li = li; hipLaunchKernelGGL(mk_fwd, dim3(grid), dim3(NTHR), LDS_BYTES, st, a); };
#if DBG == 1
    run(0, 1, 0); run(1, 2, 0);
    cmp(ws + WS_US, 1, 0, 2048, 0, P0, 2048, 0, R, 1024, 0, 1);
    cmp(ws + WS_US, 1, 0, 2048, 1024, P0, 2048, 1024, R, 1024, 1, 2);
    run(2, 3, 0); cmp(ws + WS_POOLED, 1, 0, 1024, 0, pooled, 1024, 0, R, 1024, 0, 3);
    run(3, 4, 0); cmp(ws + WS_Y, 1, 0, 1024, 0, y, 1024, 0, R, 1024, 0, 4);
    run(4, 5, 0); cmp(d_out, 0, 0, 1024, 0, h1, 1024, 0, R, 1024, 0, 5); cmp(ws + WS_H1B, 1, 0, 1024, 0, h1, 1024, 0, R, 1024, 0, 6);
    run(5, 6, 0);
    cmp(ws + WS_QKVG, 1, 0, 3072, 0, proj, 3088, 0, R, 512, 2, 7);
    cmp(ws + WS_QKVG, 1, 0, 3072, 512, proj, 3088, 512, R, 1536, 0, 8);
    cmp(ws + WS_QKVG, 1, 0, 3072, 2048, proj, 3088, 2048, R, 1024, 1, 9);
    cmp(ws + WS_GKL, 0, 0, 16, 0, proj, 3088, 3072, R, 16, 0, 10);
    run(6, 7, 0);
    cmp(ws + WS_QP, 1, 0, 512, 0, qp, 512, 0, R, 512, 0, 11);
    cmp(ws + WS_KDT, 1, 1, 0, 0, kd, 512, 0, R, 512, 0, 12);
    cmp(ws + WS_SC, 1, 0, 64, 0, scores, 64, 0, (R / 64) * 4 * 64, 64, 0, 13);
    cmp(ws + WS_DECAY, 0, 0, 512, 0, decay, 512, 0, R / 64, 512, 0, 14);
    run(7, 8, 0); cmp(ws + WS_O, 1, 0, 1024, 0, o, 1024, 0, R, 1024, 0, 15);
    run(8, 9, 0); cmp(ws + WS_Y2, 1, 0, 1024, 0, y2, 1024, 0, R, 1024, 0, 16);
    run(9, 10, 0); cmp(d_out, 0, 0, 1024, 0, h2, 1024, 0, R, 1024, 0, 17);
    run(10, 11, 0); cmp(d_out, 0, 0, 1024, 0, outr, 1024, 0, R, 1024, 0, 18);
#else
    run(0, NPH, 0);
    cmp(ws + WS_Y2, 1, 0, 1024, 0, y2, 1024, 0, R, 1024, 0, 16);
    cmp(d_out, 0, 0, 1024, 0, outr, 1024, 0, R, 1024, 0, 18);
#endif
    dbg::k_encode<<<(unsigned)(((long)M * D + 255) / 256), 256, 0, st>>>((float*)d_out, (long)M * D, slots, 19, DBG_ONLY);
#endif
}
```

```cpp
#include <hip/hip_runtime.h>
#include <cstdio>
#include <cstdint>
#define DBG 0
#define DBG_ONLY 0
#define PROBE_PHASE (-1)
namespace pg8 {
#define PG8_LAS __attribute__((address_space(3)))
typedef unsigned short bf16_t;
typedef short bf16x8 __attribute__((ext_vector_type(8)));
typedef float f32x4 __attribute__((ext_vector_type(4)));
typedef float f32x2 __attribute__((ext_vector_type(2)));
typedef unsigned u32x4 __attribute__((ext_vector_type(4)));
typedef unsigned u32x2 __attribute__((ext_vector_type(2)));
constexpr int BM = 256, BK = 64, HALF = 128, HTB = HALF * BK * 2, STAGE_BYTES = 8 * HTB, NXCD = 8, WGM = 8;

__host__ __device__ __forceinline__ int lds_byte(int r, int c) { const int st = (r >> 4) * 2 + (c >> 5), rr = r & 15, cc = c & 31, ob = rr * 64 + cc * 2; return st * 1024 + (ob ^ (((ob >> 9) & 1) << 5)); }
__host__ __device__ __forceinline__ void stage_rc(int b, int& R, int& C) { const int st = b / 1024, sb = b % 1024, swz = sb ^ (((sb >> 9) & 1) << 5); R = (st >> 1) * 16 + swz / 64; C = (st & 1) * 32 + (swz % 64) / 2; }
__host__ __device__ __forceinline__ int perm32(int rho) { const int n = rho >> 4, i = rho & 15; return 8 * (i >> 2) + 4 * n + (i & 3); }

struct Unit { int pm, pn; };
struct Gemm { const bf16_t* A; const bf16_t* Bt; int lda, ldb, K, apn; };

struct StaticOrder {
    int nM, nN, nwg, G, c;
    __host__ __device__ void init(int M, int N, int G_, int c_) { nM = M / BM; nN = N / BM; nwg = nM * nN; G = G_; c = c_; }
    __host__ __device__ bool next(int i, Unit& u) const {
        const long L = (long)i * G + c; if (L >= nwg) return false;
        int wgid = (int)L; { const int q = nwg / NXCD, r = nwg % NXCD, xcd = wgid % NXCD, off = wgid / NXCD; wgid = (xcd < r ? xcd * (q + 1) : r * (q + 1) + (xcd - r) * q) + off; }
        const int nig = WGM * nN, gid = wgid / nig, fm = gid * WGM, gsz = (nM - fm) < WGM ? (nM - fm) : WGM;
        u.pm = fm + ((wgid % nig) % gsz); u.pn = (wgid % nig) / gsz; return true;
    }
};

__device__ __forceinline__ unsigned cvt_pk_bf16(float lo, float hi) { unsigned r; asm volatile("v_cvt_pk_bf16_f32 %0, %1, %2" : "=v"(r) : "v"(lo), "v"(hi)); return r; }

template <class Epi, bool ALIGN_EPI>
__device__ __forceinline__ void gemm_phase(PG8_LAS unsigned char* lds, const Gemm g, const StaticOrder& S, const Epi& E) {
    int tid_ = threadIdx.x; asm volatile("" : "+v"(tid_));
    const int tid = tid_, wid = __builtin_amdgcn_readfirstlane(tid >> 6), lane = tid & 63, wr = wid >> 2, wc = wid & 3, fr = lane & 15, fq = lane >> 4;
    int K_ = g.K; asm volatile("" : "+s"(K_));
    const int K = K_, nt = K / BK;
    unsigned voffA[2], voffB[2];
#pragma unroll
    for (int i = 0; i < 2; ++i) { int R, C; stage_rc(tid * 16 + i * 8192, R, C); const int Rb = Epi::PERM ? ((R & ~31) + perm32(R & 31)) : R;
        voffA[i] = (unsigned)(R * g.lda + C) * 2u; voffB[i] = (unsigned)(Rb * g.ldb + C) * 2u; }
    const size_t kstep = (size_t)(BK * 2);
    const size_t hA = (size_t)HALF * g.lda * 2, hB = (size_t)HALF * g.ldb * 2;
    const unsigned ldsw = (unsigned)wid * 1024u;
    const int aoff = lds_byte(wr * 64 + fr, fq * 8), boff = lds_byte(wc * 32 + fr, fq * 8);
#define PG8_UA(u) ((const char*)g.A + ((size_t)(u).pm * 256 * g.lda + (size_t)(u).pn * g.apn) * 2)
#define PG8_UB(u) ((const char*)g.Bt + ((size_t)(u).pn * 256 * g.ldb) * 2)
#define PG8_SA(b, h) (((b) * 2 + (h)) * HTB)
#define PG8_SB(b, h) ((4 + (b) * 2 + (h)) * HTB)
#define PG8_STAGE(bufoff, gbase, voff) do { _Pragma("unroll") for (int _i = 0; _i < 2; ++_i) \
        __builtin_amdgcn_global_load_lds((const unsigned*)((const char*)(gbase) + (voff)[_i]), (PG8_LAS unsigned*)(lds + (bufoff) + ldsw + _i * 8192), 16, 0, 0); } while (0)
#define PG8_LDA(dst, b, h) do { _Pragma("unroll") for (int m = 0; m < 4; ++m) _Pragma("unroll") for (int k = 0; k < 2; ++k) dst[m][k] = *(const PG8_LAS bf16x8*)(lds + PG8_SA(b, h) + aoff + m * 2048 + k * 1024); } while (0)
#define PG8_LDB(dst, b, h) do { _Pragma("unroll") for (int n = 0; n < 2; ++n) _Pragma("unroll") for (int k = 0; k < 2; ++k) dst[n][k] = *(const PG8_LAS bf16x8*)(lds + PG8_SB(b, h) + boff + n * 2048 + k * 1024); } while (0)
#define PG8_MMA(ai, bj, At, Bt) do { __builtin_amdgcn_s_setprio(1); _Pragma("unroll") for (int m = 0; m < 4; ++m) _Pragma("unroll") for (int n = 0; n < 2; ++n) _Pragma("unroll") for (int k = 0; k < 2; ++k) \
        acc[ai][bj][m][n] = __builtin_amdgcn_mfma_f32_16x16x32_bf16(Bt[n][k], At[m][k], acc[ai][bj][m][n], 0, 0, 0); __builtin_amdgcn_s_setprio(0); } while (0)
#define PG8_WAIT_V(n) asm volatile("s_waitcnt vmcnt(" #n ")" ::: "memory")
#define PG8_WAIT_L(n) asm volatile("s_waitcnt lgkmcnt(" #n ")" ::: "memory")
#define PG8_BAR __builtin_amdgcn_s_barrier()
#define PG8_SCHED __builtin_amdgcn_sched_barrier(0)
    Unit cur, nxt; int ui = 0;
    if (!S.next(0, cur)) return;
    f32x4 acc[2][2][4][2];
#pragma unroll
    for (int a = 0; a < 2; ++a)
#pragma unroll
        for (int b = 0; b < 2; ++b)
#pragma unroll
            for (int m = 0; m < 4; ++m)
#pragma unroll
                for (int n = 0; n < 2; ++n) acc[a][b][m][n] = (f32x4){0.f, 0.f, 0.f, 0.f};
    bf16x8 At[4][2], B0[2][2], B1[2][2];
    const char* cA = PG8_UA(cur); const char* cB = PG8_UB(cur);
    PG8_STAGE(PG8_SB(0, 0), cB, voffB); PG8_STAGE(PG8_SB(0, 1), cB + hB, voffB); PG8_STAGE(PG8_SA(0, 0), cA, voffA); PG8_STAGE(PG8_SA(0, 1), cA + hA, voffA);
    if (wr == 1) PG8_BAR;
    PG8_WAIT_V(2); PG8_BAR;
    PG8_STAGE(PG8_SB(1, 0), cB + kstep, voffB); PG8_STAGE(PG8_SA(1, 0), cA + kstep, voffA); PG8_STAGE(PG8_SB(1, 1), cB + hB + kstep, voffB);
    PG8_WAIT_V(6); PG8_BAR;
    for (;;) {
        const bool has_next = S.next(ui + 1, nxt);
        const char* nA = has_next ? PG8_UA(nxt) : cA; const char* nB = has_next ? PG8_UB(nxt) : cB;
        for (int t = 0; t < nt; t += 2) {
            const bool last = (t == nt - 2);
            const char* a1 = cA + (size_t)(t + 1) * kstep;
            const char* a2 = last ? nA : cA + (size_t)(t + 2) * kstep; const char* b2 = last ? nB : cB + (size_t)(t + 2) * kstep;
            const char* a3 = a2 + kstep; const char* b3 = b2 + kstep;
            PG8_LDB(B0, 0, 0); PG8_LDB(B1, 0, 1); PG8_SCHED; PG8_LDA(At, 0, 0); PG8_STAGE(PG8_SA(1, 1), a1 + hA, voffA);
            PG8_WAIT_V(8); PG8_WAIT_L(0); PG8_BAR; PG8_MMA(0, 0, At, B0); PG8_MMA(0, 1, At, B1); PG8_BAR; PG8_SCHED;
            PG8_LDA(At, 0, 1); PG8_STAGE(PG8_SB(0, 0), b2, voffB); PG8_STAGE(PG8_SB(0, 1), b2 + hB, voffB); PG8_STAGE(PG8_SA(0, 0), a2, voffA);
            PG8_WAIT_V(8); PG8_WAIT_L(0); PG8_BAR; PG8_MMA(1, 0, At, B0); PG8_MMA(1, 1, At, B1); PG8_BAR; PG8_SCHED;
            PG8_LDB(B0, 1, 0); PG8_LDB(B1, 1, 1); PG8_SCHED; PG8_LDA(At, 1, 0); PG8_STAGE(PG8_SA(0, 1), a2 + hA, voffA);
            PG8_WAIT_V(8); PG8_WAIT_L(0); PG8_BAR; PG8_MMA(0, 0, At, B0); PG8_MMA(0, 1, At, B1); PG8_BAR; PG8_SCHED;
            PG8_LDA(At, 1, 1); PG8_STAGE(PG8_SB(1, 0), b3, voffB); PG8_STAGE(PG8_SB(1, 1), b3 + hB, voffB); PG8_STAGE(PG8_SA(1, 0), a3, voffA);
            PG8_WAIT_V(8); PG8_WAIT_L(0); PG8_BAR; PG8_MMA(1, 0, At, B0); PG8_MMA(1, 1, At, B1); PG8_BAR; PG8_SCHED;
        }
        if constexpr (ALIGN_EPI) { if (wr == 0) PG8_BAR; }
        if constexpr (!Epi::AFTER_DRAIN) { E(acc, cur, wr, wc, fr, fq); }
        if (!has_next) break;
#pragma unroll
        for (int a = 0; a < 2; ++a)
#pragma unroll
            for (int b = 0; b < 2; ++b)
#pragma unroll
                for (int m = 0; m < 4; ++m)
#pragma unroll
                    for (int n = 0; n < 2; ++n) acc[a][b][m][n] = (f32x4){0.f, 0.f, 0.f, 0.f};
        cur = nxt; cA = nA; cB = nB; ++ui;
        if constexpr (ALIGN_EPI) { if (wr == 1) PG8_BAR; }
    }
    PG8_WAIT_V(0);
    if constexpr (!ALIGN_EPI) { if (wr == 0) PG8_BAR; }
    PG8_BAR;
    if constexpr (Epi::AFTER_DRAIN) { E.fused(acc, cur, wr, wc, fr, fq, lds, wid, lane); }
#undef PG8_UA
#undef PG8_UB
#undef PG8_SA
#undef PG8_SB
#undef PG8_STAGE
#undef PG8_LDA
#undef PG8_LDB
#undef PG8_MMA
#undef PG8_WAIT_V
#undef PG8_WAIT_L
#undef PG8_BAR
#undef PG8_SCHED
}
}
constexpr int NWAVES = 8, NTHR = NWAVES * 64;
constexpr int D = 1024, SEQ = 4096, BATCH = 4, M = BATCH * SEQ;
constexpr int CHUNK = 64, NCH = SEQ / CHUNK;
constexpr int GIN = 3088, NQKVG = 3072;
constexpr float EPS = 1e-6f;
constexpr int NPH = 11;

constexpr size_t MiB = 1u << 20;
constexpr size_t WS_CTL = 0, CTL_ZERO_BYTES = 1 * MiB;
constexpr size_t WS_W1T = 1 * MiB, WS_GWT = 5 * MiB, WS_W3T = 6 * MiB, WS_W4T = 8 * MiB, WS_W6T = 15 * MiB;
constexpr size_t WS_RSTD0 = 17 * MiB, WS_SSQ1 = 17 * MiB + 64 * 1024, WS_SSQ2 = 17 * MiB + 320 * 1024;
constexpr size_t WS_GKL = 18 * MiB, WS_DSEG = 19 * MiB;
constexpr size_t WS_XB = 24 * MiB, WS_US = 56 * MiB, WS_QKVG = 24 * MiB;
constexpr size_t WS_POOLED = 120 * MiB, WS_FS = 120 * MiB;
constexpr size_t WS_Y = 152 * MiB, WS_GS = 152 * MiB;
constexpr size_t WS_H1B = 184 * MiB, WS_Y2 = 184 * MiB;
constexpr size_t WS_DBG = 216 * MiB, WS_END = 256 * MiB;
constexpr int CW_BAR = 4096, N_BAR_REGIONS = 12;

constexpr int RING_BYTES = 131072, LDS_BYTES = 147456, LDSCTL_OFF = LDS_BYTES - 1024, MISC_OFF = LDSCTL_OFF + 320;

#define GAS __attribute__((address_space(1)))
#define LAS __attribute__((address_space(3)))
typedef unsigned short bf16;
typedef unsigned v4u __attribute__((ext_vector_type(4)));
typedef unsigned v2u __attribute__((ext_vector_type(2)));
typedef float f32x4 __attribute__((ext_vector_type(4)));
typedef short bf16x8 __attribute__((ext_vector_type(8)));
typedef GAS unsigned gu32;
#define RLX_AGENT __ATOMIC_RELAXED, __HIP_MEMORY_SCOPE_AGENT
#define LDS_WAIT() asm volatile("s_waitcnt lgkmcnt(0)" ::: "memory")
#define VM_WAIT() asm volatile("s_waitcnt vmcnt(0)" ::: "memory")
__device__ __forceinline__ unsigned f2bf(float f) { unsigned u = __builtin_bit_cast(unsigned, f); return (u + 0x7fffu + ((u >> 16) & 1u)) >> 16; }
__device__ __forceinline__ unsigned pk2(float lo, float hi) { return f2bf(lo) | (f2bf(hi) << 16); }
__device__ __forceinline__ float bf2f(unsigned h) { return __builtin_bit_cast(float, h << 16); }
__device__ __forceinline__ float bflo(unsigned w) { return __builtin_bit_cast(float, w << 16); }
__device__ __forceinline__ float bfhi(unsigned w) { return __builtin_bit_cast(float, w & 0xffff0000u); }
__device__ __forceinline__ float fsilu(float v) { return v * __builtin_amdgcn_rcpf(1.f + __builtin_amdgcn_exp2f(-1.4426950408889634f * v)); }
__device__ __forceinline__ float wave_sum(float v) {
#pragma unroll
    for (int o = 1; o < 64; o <<= 1) v += __shfl_xor(v, o);
    return v;
}

#define XB_TMO      128
#define XB_XCNT(j)  (256  + 64 * (j))
#define XB_XSUB(j)  (1280 + 64 * (j))
#define XB_XGEN(j)  (2304 + 64 * (j))
#define XB_TOP      3328
#define XB_TOPGEN   3392
#define XCD_BAR_WORDS 3456
#define XB_SPIN_CAP (1u << 18)
__device__ __forceinline__ unsigned xb_ld(unsigned* p)              { return __hip_atomic_load(p, __ATOMIC_RELAXED, __HIP_MEMORY_SCOPE_AGENT); }
__device__ __forceinline__ unsigned xb_add(unsigned* p, unsigned v) { return __hip_atomic_fetch_add(p, v, __ATOMIC_RELAXED, __HIP_MEMORY_SCOPE_AGENT); }
__device__ __forceinline__ unsigned xb_xcc_id() { return (unsigned)__builtin_amdgcn_s_getreg((3 << 11) | 20) & 0xFu; }
#define XB_SPIN(cond, bar) do { unsigned _sp = 0; while (cond) { __builtin_amdgcn_s_sleep(1); \
    if ((++_sp & 255u) == 0u) { if (xb_ld(&(bar)[XB_TMO])) break; if (_sp > XB_SPIN_CAP) { atomicAdd(&(bar)[XB_TMO], 1u); break; } } } } while (0)
struct XcdBarrier { unsigned* bar; unsigned x; volatile LAS unsigned* st; };
__device__ __forceinline__ XcdBarrier xcd_barrier_post(unsigned* bar, volatile LAS unsigned* st) {
    XcdBarrier b; b.bar = bar; b.x = xb_xcc_id(); b.st = st;
    if (threadIdx.x == 0) (void)xb_add(&bar[XB_XCNT(b.x)], 1u);
    return b;
}
__device__ __forceinline__ void xcd_barrier_complete(unsigned* bar, unsigned x, unsigned& nloc, unsigned& nx) {
    const unsigned G = gridDim.x * gridDim.y * gridDim.z;
    unsigned sum, cnt, mine, sp = 0u;
    for (;;) {
        sum = 0u; cnt = 0u; mine = 0u;
#pragma unroll
        for (unsigned j = 0; j < 16; ++j) { const unsigned c = xb_ld(&bar[XB_XCNT(j)]); sum += c; cnt += (c > 0u) ? 1u : 0u; mine = (j == x) ? c : mine; }
        if (sum == G) break;
        __builtin_amdgcn_s_sleep(1);
        if ((++sp & 255u) == 0u) { if (xb_ld(&bar[XB_TMO])) break; if (sp > XB_SPIN_CAP) { atomicAdd(&bar[XB_TMO], 1u); break; } }
    }
    nloc = mine > 0u ? mine : 1u; nx = cnt > 0u ? cnt : 1u;
}
__device__ __forceinline__ void xcd_barrier(const XcdBarrier& b) {
    asm volatile("s_waitcnt vmcnt(0)" ::: "memory");
    __syncthreads();
    if (threadIdx.x == 0) {
        unsigned* bar = b.bar;
        __builtin_amdgcn_s_waitcnt(0);
        unsigned nloc = b.st[0], nx = b.st[1];
        if (nloc == 0u) { xcd_barrier_complete(bar, b.x, nloc, nx); b.st[0] = nloc; b.st[1] = nx; }
        const unsigned old = xb_add(&bar[XB_XSUB(b.x)], 1u);
        const unsigned gen = old / nloc;
        if (old + 1u == (gen + 1u) * nloc) {
            __builtin_amdgcn_fence(__ATOMIC_RELEASE, "agent");
            asm volatile("s_waitcnt vmcnt(0)" ::: "memory");
            const unsigned og = xb_add(&bar[XB_TOP], 1u);
            const unsigned tg = og / nx;
            if (og + 1u == (tg + 1u) * nx) xb_add(&bar[XB_TOPGEN], 1u);
            else XB_SPIN(xb_ld(&bar[XB_TOPGEN]) == tg, bar);
            __builtin_amdgcn_fence(__ATOMIC_ACQUIRE, "agent");
            xb_add(&bar[XB_XGEN(b.x)], 1u);
            asm volatile("s_waitcnt vmcnt(0)" ::: "memory");
        } else {
            XB_SPIN(xb_ld(&bar[XB_XGEN(b.x)]) == gen, bar);
            __builtin_amdgcn_fence(__ATOMIC_ACQUIRE, "agent");
            asm volatile("s_waitcnt vmcnt(0)" ::: "memory");
        }
    }
    __syncthreads();
}

struct Frame {
    LAS unsigned char* lds;
    int tid, lane, wave, vcu, G;
    unsigned char* ws;
    const float* in[13];
    float* out;
};
using pg8::Unit;
struct Epi1 {
    static constexpr bool PERM = true, AFTER_DRAIN = false;
    bf16* US; const float* rstd0;
    __device__ __forceinline__ void operator()(const f32x4 (&acc)[2][2][4][2], const Unit& u, int wr, int wc, int fr, int fq) const {
        const int row0 = u.pm * 256 + wr * 64 + fr, col0 = u.pn * 256 + wc * 32 + 8 * fq; const bool gate = u.pn >= 4;
#pragma unroll
        for (int ai = 0; ai < 2; ++ai)
#pragma unroll
            for (int m = 0; m < 4; ++m) { const int row = row0 + ai * 128 + m * 16; const float rs = rstd0[row]; bf16* rowp = US + (size_t)row * 2048 + col0;
#pragma unroll
                for (int bj = 0; bj < 2; ++bj) { f32x4 v0 = acc[ai][bj][m][0] * rs, v1 = acc[ai][bj][m][1] * rs;
                    if (gate) {
#pragma unroll
                        for (int e = 0; e < 4; ++e) { v0[e] = fsilu(v0[e]); v1[e] = fsilu(v1[e]); } }
                    v4u w; w.x = pg8::cvt_pk_bf16(v0[0], v0[1]); w.y = pg8::cvt_pk_bf16(v0[2], v0[3]); w.z = pg8::cvt_pk_bf16(v1[0], v1[1]); w.w = pg8::cvt_pk_bf16(v1[2], v1[3]);
                    *(v4u*)(rowp + bj * 128) = w; } }
    }
};
struct Epi2 {
    static constexpr bool PERM = true, AFTER_DRAIN = false;
    bf16* Y; const bf16* US; const float* gb; const float* sc;
    __device__ __forceinline__ void operator()(const f32x4 (&acc)[2][2][4][2], const Unit& u, int wr, int wc, int fr, int fq) const {
        const int row0 = u.pm * 256 + wr * 64 + fr, col0 = u.pn * 256 + wc * 32 + 8 * fq;
        f32x4 bv[2][2], sv[2][2];
#pragma unroll
        for (int bj = 0; bj < 2; ++bj)
#pragma unroll
            for (int n = 0; n < 2; ++n) { bv[bj][n] = *(const f32x4*)(gb + col0 + bj * 128 + 4 * n); sv[bj][n] = *(const f32x4*)(sc + col0 + bj * 128 + 4 * n); }
#pragma unroll
        for (int ai = 0; ai < 2; ++ai)
#pragma unroll
            for (int m = 0; m < 4; ++m) { const int row = row0 + ai * 128 + m * 16;
#pragma unroll
                for (int bj = 0; bj < 2; ++bj) { const v4u g = *(const v4u*)(US + (size_t)row * 2048 + 1024 + col0 + bj * 128);
                    f32x4 v0 = (acc[ai][bj][m][0] + bv[bj][0]) * sv[bj][0], v1 = (acc[ai][bj][m][1] + bv[bj][1]) * sv[bj][1];
                    v0[0] *= bflo(g.x); v0[1] *= bfhi(g.x); v0[2] *= bflo(g.y); v0[3] *= bfhi(g.y); v1[0] *= bflo(g.z); v1[1] *= bfhi(g.z); v1[2] *= bflo(g.w); v1[3] *= bfhi(g.w);
                    v4u w; w.x = pg8::cvt_pk_bf16(v0[0], v0[1]); w.y = pg8::cvt_pk_bf16(v0[2], v0[3]); w.z = pg8::cvt_pk_bf16(v1[0], v1[1]); w.w = pg8::cvt_pk_bf16(v1[2], v1[3]);
                    *(v4u*)(Y + (size_t)row * 1024 + col0 + bj * 128) = w; } }
    }
};
template <bool WB> struct EpiRes {
    static constexpr bool PERM = false, AFTER_DRAIN = true;
    const float* base; float* out; bf16* hb; float* ssq;
    __device__ __forceinline__ void fused(f32x4 (&acc)[2][2][4][2], const Unit& u, int wr, int wc, int fr, int fq, PG8_LAS unsigned char* lds, int wid, int lane) const {
        PG8_LAS float* P = (PG8_LAS float*)lds;
        const int col0 = u.pn * 256 + wc * 32 + 4 * fq;
#pragma unroll
        for (int ai = 0; ai < 2; ++ai)
#pragma unroll
            for (int m = 0; m < 4; ++m) { const int rl = ai * 128 + wr * 64 + m * 16 + fr; const size_t off = (size_t)(u.pm * 256 + rl) * 1024 + col0; float s = 0.f;
#pragma unroll
                for (int bj = 0; bj < 2; ++bj)
#pragma unroll
                    for (int n = 0; n < 2; ++n) { const f32x4 h = *(const f32x4*)(base + off + bj * 128 + n * 16) + acc[ai][bj][m][n];
                        *(f32x4*)(out + off + bj * 128 + n * 16) = h;
                        if (WB) { v2u w; w.x = pg8::cvt_pk_bf16(h[0], h[1]); w.y = pg8::cvt_pk_bf16(h[2], h[3]); *(v2u*)(hb + off + bj * 128 + n * 16) = w; }
                        s += (h[0] * h[0] + h[1] * h[1]) + (h[2] * h[2] + h[3] * h[3]); }
                s += __shfl_xor(s, 16); s += __shfl_xor(s, 32);
                if (fq == 0) P[rl * 4 + wc] = s; }
        asm volatile("s_waitcnt lgkmcnt(0)" ::: "memory"); __builtin_amdgcn_s_barrier(); asm volatile("" ::: "memory");
        const int tid = wid * 64 + lane;
        if (tid < 256) { const float s = (P[tid * 4 + 0] + P[tid * 4 + 1]) + (P[tid * 4 + 2] + P[tid * 4 + 3]); ssq[(size_t)u.pn * M + u.pm * 256 + tid] = s; }
        asm volatile("s_waitcnt lgkmcnt(0)" ::: "memory"); __builtin_amdgcn_s_barrier(); asm volatile("" ::: "memory");
    }
};
__device__ __forceinline__ float rstd_from4(const float* ssq, int row) {
    const float s = (ssq[row] + ssq[M + row]) + (ssq[2 * M + row] + ssq[3 * M + row]);
    return __builtin_amdgcn_rsqf(s * (1.f / 1024.f) + EPS);
}
struct Epi4 {
    static constexpr bool PERM = true, AFTER_DRAIN = false;
    bf16* O; const float* ssq1;
    __device__ __forceinline__ void operator()(const f32x4 (&acc)[2][2][4][2], const Unit& u, int wr, int wc, int fr, int fq) const {
        const int row0 = u.pm * 256 + wr * 64 + fr, col0 = u.pn * 256 + wc * 32 + 8 * fq; const bool gate = u.pn >= 8; const float qs = u.pn < 2 ? 0.08838834764831845f : 1.f;
#pragma unroll
        for (int ai = 0; ai < 2; ++ai)
#pragma unroll
            for (int m = 0; m < 4; ++m) { const int row = row0 + ai * 128 + m * 16; const float rs = rstd_from4(ssq1, row) * qs; bf16* rowp = O + (size_t)row * NQKVG + col0;
#pragma unroll
                for (int bj = 0; bj < 2; ++bj) { f32x4 v0 = acc[ai][bj][m][0] * rs, v1 = acc[ai][bj][m][1] * rs;
                    if (gate) {
#pragma unroll
                        for (int e = 0; e < 4; ++e) { v0[e] = fsilu(v0[e]); v1[e] = fsilu(v1[e]); } }
                    v4u w; w.x = pg8::cvt_pk_bf16(v0[0], v0[1]); w.y = pg8::cvt_pk_bf16(v0[2], v0[3]); w.z = pg8::cvt_pk_bf16(v1[0], v1[1]); w.w = pg8::cvt_pk_bf16(v1[2], v1[3]);
                    *(v4u*)(rowp + bj * 128) = w; } }
    }
};

#define PHASE_IDS() int tid_ = F.tid; asm volatile("" : "+v"(tid_)); const int tid = tid_, lane = tid & 63; (void)lane
__device__ __forceinline__ void p0_transpose_item(const float* W, int K, int N, const float* ks, bf16* WT, LAS float* scr, int item, int lane) {
    const int nblk = (N + 31) / 32, kb = item / nblk, nb = item % nblk, k0 = 64 * kb, n0 = 32 * nb;
    const int n_in = n0 + (lane & 31);
#pragma unroll 8
    for (int i = 0; i < 32; ++i) { const int kk = 2 * i + (lane >> 5); float v = (n_in < N) ? W[(size_t)(k0 + kk) * N + n_in] : 0.f; if (ks) v *= ks[k0 + kk]; scr[kk * 33 + (lane & 31)] = v; }
    LDS_WAIT(); asm volatile("" ::: "memory");
    const int c = lane & 7;
#pragma unroll
    for (int j = 0; j < 4; ++j) { const int n = (lane >> 3) + 8 * j; const LAS float* s = scr + (8 * c) * 33 + n;
        v4u o; o.x = pk2(s[0 * 33], s[1 * 33]); o.y = pk2(s[2 * 33], s[3 * 33]); o.z = pk2(s[4 * 33], s[5 * 33]); o.w = pk2(s[6 * 33], s[7 * 33]);
        *(GAS v4u*)(WT + (size_t)(n0 + n) * K + k0 + 8 * c) = o; }
    LDS_WAIT(); asm volatile("" ::: "memory");
}
__device__ __forceinline__ void phase_prep(Frame& F) {
    PHASE_IDS();
    LAS float* scr = (LAS float*)(F.lds + F.wave * 16384);
    const int gw = F.vcu * NWAVES + F.wave, NGW = F.G * NWAVES;
    constexpr int I1 = 16 * 64, IG = 4 * 8, I3 = 16 * 32, I4 = 16 * 97, I6 = 16 * 32;
    constexpr int NITEMS = I1 + 4 * IG + I3 + I4 + I6;
    const float* nw = F.in[1];
    for (int it = gw; it < NITEMS; it += NGW) {
        int r = it;
        if (r < I1) { p0_transpose_item(F.in[2], 1024, 2048, nw, (bf16*)(F.ws + WS_W1T), scr, r, lane); continue; } r -= I1;
        if (r < 4 * IG) { const int g = r / IG; p0_transpose_item(F.in[3] + (size_t)g * 65536, 256, 256, nullptr, (bf16*)(F.ws + WS_GWT) + (size_t)g * 65536, scr, r % IG, lane); continue; } r -= 4 * IG;
        if (r < I3) { p0_transpose_item(F.in[6], 1024, 1024, nullptr, (bf16*)(F.ws + WS_W3T), scr, r, lane); continue; } r -= I3;
        if (r < I4) { p0_transpose_item(F.in[7], 1024, GIN, nw + 1024, (bf16*)(F.ws + WS_W4T), scr, r, lane); continue; } r -= I4;
        p0_transpose_item(F.in[11], 1024, 1024, nullptr, (bf16*)(F.ws + WS_W6T), scr, r, lane);
    }
    const float* x = F.in[0]; bf16* XB = (bf16*)(F.ws + WS_XB); float* rstd0 = (float*)(F.ws + WS_RSTD0);
    for (int m = gw; m < M; m += NGW) {
        const GAS f32x4* xr = (const GAS f32x4*)(x + (size_t)m * D) + lane;
        f32x4 v[4]; float s = 0.f;
#pragma unroll
        for (int j = 0; j < 4; ++j) { v[j] = xr[64 * j]; s += (v[j].x * v[j].x + v[j].y * v[j].y) + (v[j].z * v[j].z + v[j].w * v[j].w); }
        s = wave_sum(s);
        if (lane == 0) rstd0[m] = __builtin_amdgcn_rsqf(s * (1.f / D) + EPS);
        GAS v2u* o8 = (GAS v2u*)(XB + (size_t)m * D) + lane;
#pragma unroll
        for (int j = 0; j < 4; ++j) { v2u w; w.x = pk2(v[j].x, v[j].y); w.y = pk2(v[j].z, v[j].w); o8[64 * j] = w; }
    }
}
__device__ __forceinline__ void unpack8(const v4u w, float (&f)[8]) { f[0] = bflo(w.x); f[1] = bfhi(w.x); f[2] = bflo(w.y); f[3] = bfhi(w.y); f[4] = bflo(w.z); f[5] = bfhi(w.z); f[6] = bflo(w.w); f[7] = bfhi(w.w); }
__device__ __forceinline__ void phase_pool(Frame& F) {
    PHASE_IDS();
    const bf16* US = (const bf16*)(F.ws + WS_US); bf16* PO = (bf16*)(F.ws + WS_POOLED);
    for (int gid = F.vcu * NTHR + tid; gid < 1024 * 128; gid += F.G * NTHR) {
        const int c8 = gid & 127, run = gid >> 7, t0 = run * 16, pos0 = t0 & (SEQ - 1), w = 2 << (c8 >> 5);
        const bf16* up = US + (size_t)t0 * 2048 + c8 * 8;
        float s[8], f[8];
#pragma unroll
        for (int e = 0; e < 8; ++e) s[e] = 0.f;
        if (pos0 > 0) for (int i = 1; i < w; ++i) { unpack8(*(const v4u*)(up - (size_t)i * 2048), f);
#pragma unroll
            for (int e = 0; e < 8; ++e) s[e] += f[e]; }
#pragma unroll 4
        for (int j = 0; j < 16; ++j) {
            unpack8(*(const v4u*)(up + (size_t)j * 2048), f);
            const int p1 = pos0 + j + 1; const float inv = 1.f / (float)(p1 < w ? p1 : w);
#pragma unroll
            for (int e = 0; e < 8; ++e) s[e] += f[e];
            v4u o; o.x = pk2(s[0] * inv - f[0], s[1] * inv - f[1]); o.y = pk2(s[2] * inv - f[2], s[3] * inv - f[3]); o.z = pk2(s[4] * inv - f[4], s[5] * inv - f[5]); o.w = pk2(s[6] * inv - f[6], s[7] * inv - f[7]);
            *(v4u*)(PO + (size_t)(t0 + j) * 1024 + c8 * 8) = o;
            if (p1 >= w) { unpack8(*(const v4u*)(up + (ptrdiff_t)(j + 1 - w) * 2048), f);
#pragma unroll
                for (int e = 0; e < 8; ++e) s[e] -= f[e]; }
        }
    }
}
__device__ __forceinline__ void phase_gklow(Frame& F) {
    PHASE_IDS();
    const bf16* H1B = (const bf16*)(F.ws + WS_H1B); const bf16* W4T = (const bf16*)(F.ws + WS_W4T); const float* ssq1 = (const float*)(F.ws + WS_SSQ1); float* GKL = (float*)(F.ws + WS_GKL);
    if (F.wave < 4) for (int item = F.vcu; item < M / 64; item += F.G) {
        const int r0 = item * 64 + F.wave * 16, l15 = lane & 15, lq = lane >> 4;
        const bf16* ap = H1B + (size_t)(r0 + l15) * 1024 + lq * 8; const bf16* bp = W4T + (size_t)(3072 + l15) * 1024 + lq * 8;
        f32x4 acc = (f32x4){0.f, 0.f, 0.f, 0.f};
#pragma unroll 8
        for (int kk = 0; kk < 32; ++kk) { const bf16x8 a = *(const bf16x8*)(ap + kk * 32), b = *(const bf16x8*)(bp + kk * 32); acc = __builtin_amdgcn_mfma_f32_16x16x32_bf16(a, b, acc, 0, 0, 0); }
#pragma unroll
        for (int r = 0; r < 4; ++r) { const int row = r0 + 4 * lq + r; GKL[(size_t)row * 16 + l15] = acc[r] * rstd_from4(ssq1, row); }
    }
}
typedef short s16x4 __attribute__((ext_vector_type(4)));
constexpr int C_QPS = 0, C_QNS = 17408, C_KPS = 34816, C_KNS = 52224, C_ROW = 272;
constexpr int C_KD = 69632, C_KDROW = 288;
constexpr int C_V = 88064, C_VROW = 544;
constexpr int C_SC = 122880, C_SCROW = 144;
constexpr int C_GL = 132096, C_TOT = 136192, C_DEC = 138240, C_NRM = 138752, C_END = 140800;
static_assert(C_END <= LDSCTL_OFF, "GLA LDS map");
__device__ __forceinline__ s16x4 ds_tr(const LAS unsigned char* p) { return __builtin_bit_cast(s16x4, __builtin_amdgcn_ds_read_tr16_b64_v4i16((LAS s16x4*)p)); }
__device__ __forceinline__ bf16x8 tr_frag(const LAS unsigned char* img, int stride, int row0, int col0, int i, int q) {
    const LAS unsigned char* p = img + (row0 + 8 * q + (i >> 2)) * stride + (col0 + 4 * (i & 3)) * 2;
    const s16x4 a = ds_tr(p), b = ds_tr(p + 4 * stride);
    return (bf16x8){a[0], a[1], a[2], a[3], b[0], b[1], b[2], b[3]};
}
template <bool FULL> __device__ __forceinline__ float chunk_elem(Frame& F, int tid, int t0, int h, const float (&w)[16], float bb) {
    const bf16* QKVG = (const bf16*)(F.ws + WS_QKVG); const float* GKL = (const float*)(F.ws + WS_GKL);
    LAS unsigned char* lds = F.lds;
    const int k = tid & 127, tg = tid >> 7;
    if (tid < 256) ((LAS f32x4*)(lds + C_GL))[tid] = ((const f32x4*)(GKL + (size_t)t0 * 16))[tid];
    unsigned short qv[16], kv[16];
    { const bf16* qb = QKVG + (size_t)(t0 + tg * 16) * NQKVG + h * 128 + k;
#pragma unroll
      for (int j = 0; j < 16; ++j) { kv[j] = qb[(size_t)j * NQKVG + 512]; if (FULL) qv[j] = qb[(size_t)j * NQKVG]; } }
#pragma unroll
    for (int i = 0; i < 4; ++i) { const int idx = tid + i * NTHR, row = idx >> 5, c16 = idx & 31;
        const v4u val = *(const v4u*)(QKVG + (size_t)(t0 + row) * NQKVG + 1024 + h * 256 + c16 * 8);
        *(LAS v4u*)(lds + C_V + row * C_VROW + c16 * 16) = val; }
    __syncthreads();
    float c[16]; float run = 0.f;
#pragma unroll
    for (int j = 0; j < 16; ++j) { const LAS float* g = (const LAS float*)(lds + C_GL) + (tg * 16 + j) * 16; float z = bb;
#pragma unroll
        for (int r = 0; r < 16; ++r) z += g[r] * w[r];
        const float ls = fminf(z, 0.f) - __logf(1.f + __expf(-fabsf(z)));
        run += ls * (1.f / 16.f); c[j] = run; }
    ((LAS float*)(lds + C_TOT))[tg * 128 + k] = run;
    __syncthreads();
    float pre = 0.f, cl = 0.f;
#pragma unroll
    for (int g = 0; g < 4; ++g) { const float tt = ((const LAS float*)(lds + C_TOT))[g * 128 + k]; pre += (g < tg) ? tt : 0.f; cl += tt; }
#pragma unroll
    for (int j = 0; j < 16; ++j) { const int t = tg * 16 + j; const float cum = pre + c[j]; const float kk = bf2f(kv[j]);
        *(LAS unsigned short*)(lds + C_KD + t * C_KDROW + k * 2) = (unsigned short)f2bf(kk * __expf(cl - cum));
        if (FULL) { const float ep = __expf(cum), en = __expf(-cum), q = bf2f(qv[j]);
            *(LAS unsigned short*)(lds + C_QPS + t * C_ROW + k * 2) = (unsigned short)f2bf(q * ep);
            *(LAS unsigned short*)(lds + C_QNS + t * C_ROW + k * 2) = (unsigned short)f2bf(q * en);
            *(LAS unsigned short*)(lds + C_KPS + t * C_ROW + k * 2) = (unsigned short)f2bf(kk * ep);
            *(LAS unsigned short*)(lds + C_KNS + t * C_ROW + k * 2) = (unsigned short)f2bf(kk * en); } }
    if (tg == 0) ((LAS float*)(lds + C_DEC))[k] = __expf(cl);
    __syncthreads();
    return cl;
}
__device__ __forceinline__ void phase_gla_a(Frame& F) {
    PHASE_IDS();
    LAS unsigned char* lds = F.lds;
    float* FS = (float*)(F.ws + WS_FS); float* DSEG = (float*)(F.ws + WS_DSEG);
    const int i15 = lane & 15, q = lane >> 4, wave = F.wave;
    for (int unit = F.vcu; unit < 256; unit += F.G) {
        const int bh = unit >> 4, g = unit & 15, b = bh >> 2, h = bh & 3;
        if (g == 15) continue;
        float w[16];
#pragma unroll
        for (int r = 0; r < 16; ++r) w[r] = F.in[8][r * 512 + h * 128 + (tid & 127)];
        const float bb = F.in[9][h * 128 + (tid & 127)];
        f32x4 S[8][2];
#pragma unroll
        for (int kt = 0; kt < 8; ++kt) { S[kt][0] = (f32x4){0.f, 0.f, 0.f, 0.f}; S[kt][1] = S[kt][0]; }
        float clsum = 0.f;
        for (int c = 0; c < 4; ++c) {
            const int t0 = b * SEQ + g * 256 + c * 64;
            clsum += chunk_elem<false>(F, tid, t0, h, w, bb);
#pragma unroll
            for (int kt = 0; kt < 8; ++kt) { const f32x4 d = *(const LAS f32x4*)(lds + C_DEC + (16 * kt + 4 * q) * 4); S[kt][0] *= d; S[kt][1] *= d; }
#pragma unroll
            for (int ts = 0; ts < 2; ++ts) {
                const bf16x8 v0 = tr_frag(lds + C_V, C_VROW, 32 * ts, 32 * wave, i15, q), v1 = tr_frag(lds + C_V, C_VROW, 32 * ts, 32 * wave + 16, i15, q);
#pragma unroll
                for (int kt = 0; kt < 8; ++kt) { const bf16x8 a = tr_frag(lds + C_KD, C_KDROW, 32 * ts, 16 * kt, i15, q);
                    S[kt][0] = __builtin_amdgcn_mfma_f32_16x16x32_bf16(a, v0, S[kt][0], 0, 0, 0); S[kt][1] = __builtin_amdgcn_mfma_f32_16x16x32_bf16(a, v1, S[kt][1], 0, 0, 0); } }
            __syncthreads();
        }
        f32x4* fo = (f32x4*)FS + ((size_t)(unit * 8 + wave) * 16) * 64 + lane;
#pragma unroll
        for (int kt = 0; kt < 8; ++kt) { fo[(kt * 2 + 0) * 64] = S[kt][0]; fo[(kt * 2 + 1) * 64] = S[kt][1]; }
        if (tid < 128) DSEG[unit * 128 + tid] = __expf(clsum);
    }
}
__device__ __forceinline__ void phase_gla_b(Frame& F) {
    PHASE_IDS();
    const f32x4* FS = (const f32x4*)(F.ws + WS_FS); f32x4* GS = (f32x4*)(F.ws + WS_GS); const float* DSEG = (const float*)(F.ws + WS_DSEG);
    for (int T = F.vcu * NTHR + tid; T < 16 * 8192; T += F.G * NTHR) {
        const int bh = T >> 13, rem = T & 8191, tile = (rem >> 6) & 15, ln = rem & 63, kt = tile >> 1, q = ln >> 4;
        f32x4 f[15], d[15];
#pragma unroll
        for (int g = 0; g < 15; ++g) { f[g] = FS[(size_t)(bh * 16 + g) * 8192 + rem]; d[g] = *(const f32x4*)(DSEG + (bh * 16 + g) * 128 + 16 * kt + 4 * q); }
        f32x4 G = (f32x4){0.f, 0.f, 0.f, 0.f};
#pragma unroll
        for (int g = 0; g < 15; ++g) { G = G * d[g] + f[g]; GS[(size_t)(bh * 16 + g + 1) * 8192 + rem] = G; }
    }
}
__device__ __forceinline__ void phase_gla_c(Frame& F) {
    PHASE_IDS();
    LAS unsigned char* lds = F.lds;
    const bf16* QKVG = (const bf16*)(F.ws + WS_QKVG); const f32x4* GS = (const f32x4*)(F.ws + WS_GS); bf16* Y2 = (bf16*)(F.ws + WS_Y2);
    const int i15 = lane & 15, q = lane >> 4, wave = F.wave;
    for (int unit = F.vcu; unit < 256; unit += F.G) {
        const int bh = unit >> 4, g = unit & 15, b = bh >> 2, h = bh & 3;
        float w[16];
#pragma unroll
        for (int r = 0; r < 16; ++r) w[r] = F.in[8][r * 512 + h * 128 + (tid & 127)];
        const float bb = F.in[9][h * 128 + (tid & 127)];
        f32x4 hw[2];
#pragma unroll
        for (int vt = 0; vt < 2; ++vt) hw[vt] = *(const f32x4*)(F.in[10] + 32 * wave + 16 * vt + 4 * q);
        f32x4 S[8][2];
        { const f32x4* gi = GS + ((size_t)(unit * 8 + wave) * 16) * 64 + lane;
#pragma unroll
          for (int kt = 0; kt < 8; ++kt)
#pragma unroll
              for (int vt = 0; vt < 2; ++vt) S[kt][vt] = (g == 0) ? (f32x4){0.f, 0.f, 0.f, 0.f} : gi[(kt * 2 + vt) * 64]; }
        for (int c = 0; c < 4; ++c) {
            const int t0 = b * SEQ + g * 256 + c * 64;
            (void)chunk_elem<true>(F, tid, t0, h, w, bb);
            v2u sg[2][4];
#pragma unroll
            for (int vt = 0; vt < 2; ++vt)
#pragma unroll
                for (int tt = 0; tt < 4; ++tt) sg[vt][tt] = *(const v2u*)(QKVG + (size_t)(t0 + 16 * tt + i15) * NQKVG + 2048 + h * 256 + 32 * wave + 16 * vt + 4 * q);
#pragma unroll
            for (int e = 0; e < 2; ++e) { const int idx = wave * 2 + e, ti = idx >> 2, si = idx & 3;
                f32x4 af = (f32x4){0.f, 0.f, 0.f, 0.f}, ab = (f32x4){0.f, 0.f, 0.f, 0.f};
                const int ao = (si * 16 + i15) * C_ROW + q * 16, bo = (ti * 16 + i15) * C_ROW + q * 16;
                if (ti >= si) {
#pragma unroll
                    for (int kk = 0; kk < 4; ++kk) af = __builtin_amdgcn_mfma_f32_16x16x32_bf16(*(const LAS bf16x8*)(lds + C_KNS + ao + kk * 64), *(const LAS bf16x8*)(lds + C_QPS + bo + kk * 64), af, 0, 0, 0); }
                if (ti <= si) {
#pragma unroll
                    for (int kk = 0; kk < 4; ++kk) ab = __builtin_amdgcn_mfma_f32_16x16x32_bf16(*(const LAS bf16x8*)(lds + C_KPS + ao + kk * 64), *(const LAS bf16x8*)(lds + C_QNS + bo + kk * 64), ab, 0, 0, 0); }
                const int t = ti * 16 + i15; float v[4];
#pragma unroll
                for (int r = 0; r < 4; ++r) { const int s_ = si * 16 + 4 * q + r; v[r] = (s_ <= t) ? af[r] : ab[r]; }
                v2u o; o.x = pk2(v[0], v[1]); o.y = pk2(v[2], v[3]);
                *(LAS v2u*)(lds + C_SC + t * C_SCROW + (si * 16 + 4 * q) * 2) = o; }
            __syncthreads();
            f32x4 o[2][4];
#pragma unroll
            for (int vt = 0; vt < 2; ++vt)
#pragma unroll
                for (int tt = 0; tt < 4; ++tt) o[vt][tt] = (f32x4){0.f, 0.f, 0.f, 0.f};
            bf16x8 Vf[2][2];
#pragma unroll
            for (int vt = 0; vt < 2; ++vt)
#pragma unroll
                for (int ts = 0; ts < 2; ++ts) Vf[vt][ts] = tr_frag(lds + C_V, C_VROW, 32 * ts, 32 * wave + 16 * vt, i15, q);
#pragma unroll
            for (int tt = 0; tt < 4; ++tt)
#pragma unroll
                for (int ss = 0; ss < 2; ++ss) { const bf16x8 scf = *(const LAS bf16x8*)(lds + C_SC + (16 * tt + i15) * C_SCROW + (32 * ss + 8 * q) * 2);
                    o[0][tt] = __builtin_amdgcn_mfma_f32_16x16x32_bf16(Vf[0][ss], scf, o[0][tt], 0, 0, 0); o[1][tt] = __builtin_amdgcn_mfma_f32_16x16x32_bf16(Vf[1][ss], scf, o[1][tt], 0, 0, 0); }
#pragma unroll
            for (int ks = 0; ks < 4; ++ks) {
                bf16x8 SA[2];
#pragma unroll
                for (int vt = 0; vt < 2; ++vt) { const f32x4 sa = S[2 * ks][vt], sb = S[2 * ks + 1][vt];
                    v4u pk; pk.x = pk2(sa[0], sa[1]); pk.y = pk2(sa[2], sa[3]); pk.z = pk2(sb[0], sb[1]); pk.w = pk2(sb[2], sb[3]); SA[vt] = __builtin_bit_cast(bf16x8, pk); }
#pragma unroll
                for (int tt = 0; tt < 4; ++tt) {
                    const LAS unsigned char* qpp = lds + C_QPS + (16 * tt + i15) * C_ROW + (32 * ks + 4 * q) * 2;
                    const v2u lo = *(const LAS v2u*)qpp, hi = *(const LAS v2u*)(qpp + 32);
                    const bf16x8 qf = __builtin_bit_cast(bf16x8, (v4u){lo.x, lo.y, hi.x, hi.y});
                    o[0][tt] = __builtin_amdgcn_mfma_f32_16x16x32_bf16(SA[0], qf, o[0][tt], 0, 0, 0); o[1][tt] = __builtin_amdgcn_mfma_f32_16x16x32_bf16(SA[1], qf, o[1][tt], 0, 0, 0); } }
#pragma unroll
            for (int kt = 0; kt < 8; ++kt) { const f32x4 d = *(const LAS f32x4*)(lds + C_DEC + (16 * kt + 4 * q) * 4); S[kt][0] *= d; S[kt][1] *= d; }
#pragma unroll
            for (int ts = 0; ts < 2; ++ts)
#pragma unroll
                for (int kt = 0; kt < 8; ++kt) { const bf16x8 a = tr_frag(lds + C_KD, C_KDROW, 32 * ts, 16 * kt, i15, q);
                    S[kt][0] = __builtin_amdgcn_mfma_f32_16x16x32_bf16(a, Vf[0][ts], S[kt][0], 0, 0, 0); S[kt][1] = __builtin_amdgcn_mfma_f32_16x16x32_bf16(a, Vf[1][ts], S[kt][1], 0, 0, 0); }
            float pt[4];
#pragma unroll
            for (int tt = 0; tt < 4; ++tt) { float p = 0.f;
#pragma unroll
                for (int vt = 0; vt < 2; ++vt) p += (o[vt][tt][0] * o[vt][tt][0] + o[vt][tt][1] * o[vt][tt][1]) + (o[vt][tt][2] * o[vt][tt][2] + o[vt][tt][3] * o[vt][tt][3]);
                p += __shfl_xor(p, 16); p += __shfl_xor(p, 32); pt[tt] = p; }
            if (q == 0) {
#pragma unroll
                for (int tt = 0; tt < 4; ++tt) ((LAS float*)(lds + C_NRM))[wave * 64 + 16 * tt + i15] = pt[tt]; }
            __syncthreads();
#pragma unroll
            for (int tt = 0; tt < 4; ++tt) { float s = 0.f;
#pragma unroll
                for (int ww = 0; ww < 8; ++ww) s += ((const LAS float*)(lds + C_NRM))[ww * 64 + 16 * tt + i15];
                const float r = __builtin_amdgcn_rsqf(s * (1.f / 256.f) + EPS);
#pragma unroll
                for (int vt = 0; vt < 2; ++vt) { const f32x4 ov = o[vt][tt]; const v2u gg = sg[vt][tt];
                    v2u y; y.x = pk2(ov[0] * r * hw[vt][0] * bflo(gg.x), ov[1] * r * hw[vt][1] * bfhi(gg.x)); y.y = pk2(ov[2] * r * hw[vt][2] * bflo(gg.y), ov[3] * r * hw[vt][3] * bfhi(gg.y));
                    *(v2u*)(Y2 + (size_t)(t0 + 16 * tt + i15) * 1024 + h * 256 + 32 * wave + 16 * vt + 4 * q) = y; } }
            __syncthreads();
        }
    }
}
__device__ __forceinline__ void phase_final(Frame& F) {
    PHASE_IDS();
    const float* ssq2 = (const float*)(F.ws + WS_SSQ2); const float* fw = F.in[12];
    const int gw = F.vcu * NWAVES + F.wave, NGW = F.G * NWAVES;
    f32x4 wv[4];
#pragma unroll
    for (int j = 0; j < 4; ++j) wv[j] = *((const f32x4*)fw + lane + 64 * j);
    for (int m = gw; m < M; m += NGW) { const float r = rstd_from4(ssq2, m);
        GAS f32x4* xr = (GAS f32x4*)(F.out + (size_t)m * D) + lane;
#pragma unroll
        for (int j = 0; j < 4; ++j) { f32x4 v = xr[64 * j]; v = v * r * wv[j]; xr[64 * j] = v; } }
}
struct Args { const float* in[13]; float* out; unsigned char* ws; int ph_lo, ph_hi, li, pad; };
__global__ void __launch_bounds__(NTHR, 2) mk_fwd(Args args) {
    extern __shared__ __attribute__((aligned(16))) unsigned char lds_raw[];
    Frame F;
    F.lds = (LAS unsigned char*)lds_raw;
    F.tid = threadIdx.x; F.lane = F.tid & 63; F.wave = __builtin_amdgcn_readfirstlane(F.tid >> 6);
    F.G = gridDim.x; { const int bx = blockIdx.x; F.vcu = (F.G % 8 == 0) ? (bx % 8) * (F.G / 8) + bx / 8 : bx; }
    F.ws = args.ws; F.out = args.out;
#pragma unroll
    for (int i = 0; i < 13; ++i) F.in[i] = args.in[i];
    volatile LAS unsigned* MISC = (volatile LAS unsigned*)(F.lds + MISC_OFF);
    for (int u = F.tid; u < (LDS_BYTES - LDSCTL_OFF) / 4; u += NTHR) ((LAS unsigned*)(F.lds + LDSCTL_OFF))[u] = 0u;
    __syncthreads();
    unsigned* ctl = (unsigned*)(F.ws + WS_CTL);
    const int lo = args.ph_lo, hi = args.ph_hi;
    XcdBarrier bar; bar.bar = ctl + CW_BAR + args.li * XCD_BAR_WORDS; bar.x = 0; bar.st = nullptr;
    if (hi - lo > 1) bar = xcd_barrier_post(ctl + CW_BAR + args.li * XCD_BAR_WORDS, MISC + 8);
#define IN(k) (lo <= (k) && (k) < hi)
#if PROBE_PHASE >= 0
#define STAMP(i) do { if (blockIdx.x == 0 && F.tid == 0) { const unsigned long long t_ = __builtin_amdgcn_s_memrealtime(); MISC[16 + 2 * (i)] = (unsigned)t_; MISC[17 + 2 * (i)] = (unsigned)(t_ >> 32); } } while (0)
#else
#define STAMP(i) do { } while (0)
#endif
#define SEAM(k) do { if (IN(k) && IN((k) + 1)) xcd_barrier(bar); STAMP((k) + 1); } while (0)
    STAMP(0);
    unsigned char* ws = F.ws;
    if (IN(0)) { phase_prep(F); } SEAM(0);
    if (IN(1)) { pg8::Gemm g{(const bf16*)(ws + WS_XB), (const bf16*)(ws + WS_W1T), 1024, 1024, 1024, 0}; pg8::StaticOrder S; S.init(M, 2048, F.G, (int)blockIdx.x);
        Epi1 E{(bf16*)(ws + WS_US), (const float*)(ws + WS_RSTD0)}; pg8::gemm_phase<Epi1, true>(F.lds, g, S, E); } SEAM(1);
    if (IN(2)) { phase_pool(F); } SEAM(2);
    if (IN(3)) { pg8::Gemm g{(const bf16*)(ws + WS_POOLED), (const bf16*)(ws + WS_GWT), 1024, 256, 256, 256}; pg8::StaticOrder S; S.init(M, 1024, F.G, (int)blockIdx.x);
        Epi2 E{(bf16*)(ws + WS_Y), (const bf16*)(ws + WS_US), F.in[4], F.in[5]}; pg8::gemm_phase<Epi2, true>(F.lds, g, S, E); } SEAM(3);
    if (IN(4)) { pg8::Gemm g{(const bf16*)(ws + WS_Y), (const bf16*)(ws + WS_W3T), 1024, 1024, 1024, 0}; pg8::StaticOrder S; S.init(M, 1024, F.G, (int)blockIdx.x);
        EpiRes<true> E{F.in[0], F.out, (bf16*)(ws + WS_H1B), (float*)(ws + WS_SSQ1)}; pg8::gemm_phase<EpiRes<true>, false>(F.lds, g, S, E); } SEAM(4);
    if (IN(5)) { pg8::Gemm g{(const bf16*)(ws + WS_H1B), (const bf16*)(ws + WS_W4T), 1024, 1024, 1024, 0}; pg8::StaticOrder S; S.init(M, NQKVG, F.G, (int)blockIdx.x);
        Epi4 E{(bf16*)(ws + WS_QKVG), (const float*)(ws + WS_SSQ1)}; pg8::gemm_phase<Epi4, true>(F.lds, g, S, E);
        phase_gklow(F); } SEAM(5);
    if (IN(6)) { phase_gla_a(F); } SEAM(6);
    if (IN(7)) { phase_gla_b(F); } SEAM(7);
    if (IN(8)) { phase_gla_c(F); } SEAM(8);
    if (IN(9)) { pg8::Gemm g{(const bf16*)(ws + WS_Y2), (const bf16*)(ws + WS_W6T), 1024, 1024, 1024, 0}; pg8::StaticOrder S; S.init(M, 1024, F.G, (int)blockIdx.x);
        EpiRes<false> E{F.out, F.out, nullptr, (float*)(ws + WS_SSQ2)}; pg8::gemm_phase<EpiRes<false>, false>(F.lds, g, S, E); } SEAM(9);
    if (IN(10)) { phase_final(F); }
#if PROBE_PHASE >= 0
    VM_WAIT(); __syncthreads(); STAMP(11);
    if (blockIdx.x == 0 && F.tid == 0) {
        const unsigned long long a_ = ((unsigned long long)MISC[17 + 2 * PROBE_PHASE] << 32) | MISC[16 + 2 * PROBE_PHASE], b_ = ((unsigned long long)MISC[17 + 2 * (PROBE_PHASE + 1)] << 32) | MISC[16 + 2 * (PROBE_PHASE + 1)];
        const unsigned long long dt_ = (b_ - a_) * 8ull, t0_ = __builtin_amdgcn_s_memrealtime();
        while (__builtin_amdgcn_s_memrealtime() - t0_ < dt_) __builtin_amdgcn_s_sleep(8);
    }
#endif
#undef IN
#undef SEAM
}
#if DBG
namespace dbg {
constexpr int ROWS = 512;
__global__ void __launch_bounds__(256) k_cmp(const void* fast, int is_bf16, int mode, long fs, long fo, const float* refp, long rs, long ro, int rows, int cols, int tr, unsigned* slots, int slot) {
    const long i = (long)blockIdx.x * 256 + threadIdx.x;
    float err = 0.f, mag = 0.f;
    if (i < (long)rows * cols) {
        const long r = i / cols, c = i % cols;
        long fi = r * fs + fo + c;
        if (mode == 1) { const long h = c >> 7, k = c & 127; fi = ((r >> 6) * 4 + h) * 8192 + k * 64 + (r & 63); }
        float a = is_bf16 ? __builtin_bit_cast(float, (unsigned)((const unsigned short*)fast)[fi] << 16) : ((const float*)fast)[fi];
        float b = refp[r * rs + ro + c];
        if (tr == 1) b = b / (1.f + __expf(-b)); else if (tr == 2) b *= 0.08838834764831845f;
        err = fabsf(a - b); mag = fabsf(b);
        if (!(err == err) || err > 3.0e38f) err = 3.0e38f;
    }
#pragma unroll
    for (int o = 1; o < 64; o <<= 1) { err = fmaxf(err, __shfl_xor(err, o)); mag = fmaxf(mag, __shfl_xor(mag, o)); }
    if ((threadIdx.x & 63) == 0) { atomicMax(slots + 2 * slot, __builtin_bit_cast(unsigned, err)); atomicMax(slots + 2 * slot + 1, __builtin_bit_cast(unsigned, mag)); }
}
__global__ void __launch_bounds__(256) k_encode(float* out, long n, const unsigned* slots, int nslots, int only_slot) {
    const long i = (long)blockIdx.x * 256 + threadIdx.x;
    if (i >= n) return;
    float v = 0.f;
    if (i == 0) {
        v = 990000.f;
        for (int s = 1; s < nslots; ++s) {
            const float err = __builtin_bit_cast(float, slots[2 * s]), mag = __builtin_bit_cast(float, slots[2 * s + 1]);
            const float rel = err / fmaxf(mag, 1e-20f);
            if (only_slot > 0) { if (s == only_slot) { v = rel * 1.0e6f + 1.0e4f; break; } continue; }
            int sev = 0;
            if (!(rel < 0.03f)) sev = rel < 0.1f ? 1 : rel < 0.3f ? 2 : rel < 1.f ? 3 : rel < 1e30f ? 4 : 5;
            if (mag == 0.f) sev = 6;
            if (sev) { v = (float)(10 * s + sev) * 1.0e4f; break; }
        }
    }
    out[i] = v;
}
}
#endif

extern "C" void kernel_launch(void* const* d_in, const int* in_sizes, int n_in, void* d_out, int out_size, void* d_ws, size_t ws_size, hipStream_t stream) {
    static int grid = 0;
    if (grid == 0) {
        if (n_in != 13 || in_sizes[0] != M * D || out_size != M * D || ws_size < WS_END) { fprintf(stderr, "kernel_launch: unexpected problem shape (n_in %d, in0 %d, out %d, ws %zu)\n", n_in, n_in > 0 ? in_sizes[0] : -1, out_size, ws_size); grid = -1; return; }
        int dev = 0, cus = 0, per_cu = 0;
        if (hipGetDevice(&dev) != hipSuccess || hipDeviceGetAttribute(&cus, hipDeviceAttributeMultiprocessorCount, dev) != hipSuccess) { grid = -1; return; }
        if (hipFuncSetAttribute((const void*)mk_fwd, hipFuncAttributeMaxDynamicSharedMemorySize, LDS_BYTES) != hipSuccess) { fprintf(stderr, "kernel_launch: hipFuncSetAttribute failed\n"); grid = -1; return; }
        if (hipOccupancyMaxActiveBlocksPerMultiprocessor(&per_cu, (const void*)mk_fwd, NTHR, LDS_BYTES) != hipSuccess || per_cu < 1) { fprintf(stderr, "kernel_launch: occupancy query says %d workgroups per CU\n", per_cu); (void)hipGetLastError(); grid = -1; return; }
        grid = cus;
    }
    if (grid < 0) return;
    (void)hipMemsetAsync((char*)d_ws + WS_CTL, 0, CTL_ZERO_BYTES, stream);
    Args a{};
    for (int i = 0; i < 13; ++i) a.in[i] = (const float*)d_in[i];
    a.out = (float*)d_out; a.ws = (unsigned char*)d_ws;
#if !DBG
    a.ph_lo = 0; a.ph_hi = NPH; a.li = 0;
    hipLaunchKernelGGL(mk_fwd, dim3(grid), dim3(NTHR), LDS_BYTES, stream, a);
#else
    unsigned char* ws = (unsigned char*)d_ws; hipStream_t st = stream;
    const int R = dbg::ROWS;
    float* rb = (float*)(ws + WS_DBG);
    size_t off = 0; auto take = [&](size_t nfl) { float* p = rb + off; off += (nfl + 63) & ~(size_t)63; return p; };
    float* P0 = take((size_t)R * 2048), *pooled = take((size_t)R * 1024), *y = take((size_t)R * 1024), *h1 = take((size_t)R * 1024), *proj = take((size_t)R * 3088), *cum = take((size_t)R * 512);
    float* qp = take((size_t)R * 512), *qn = take((size_t)R * 512), *kp = take((size_t)R * 512), *kn = take((size_t)R * 512), *kd = take((size_t)R * 512);
    float* scores = take((size_t)(R / 64) * 4 * 4096), *decay = take((size_t)(R / 64) * 512), *o = take((size_t)R * 1024), *y2 = take((size_t)R * 1024), *h2 = take((size_t)R * 1024), *outr = take((size_t)R * 1024), *rstd = take(R);
    {
        using namespace ref;
        const float* x = (const float*)d_in[0]; const float* norm_w = (const float*)d_in[1];
        auto gemm = [&](const float* A, int lda, const float* B, int ldb, float* C, int ldc, int Mr, int N, int K, const float* rs, const float* ks, const float* Rr, int ldr) {
            k_gemm<<<dim3((N + 63) / 64, Mr / 64), 256, 0, st>>>(A, lda, B, ldb, C, ldc, Mr, N, K, rs, ks, Rr, ldr); };
        k_rstd<<<R / 4, 256, 0, st>>>(x, rstd, R);
        gemm(x, 1024, (const float*)d_in[2], 2048, P0, 2048, R, 2048, 1024, rstd, norm_w, nullptr, 0);
        k_pool<<<(R * 1024) / 256, 256, 0, st>>>(P0, pooled, R);
        for (int g = 0; g < 4; ++g) gemm(pooled + g * 256, 1024, (const float*)d_in[3] + (size_t)g * 65536, 256, y + g * 256, 1024, R, 256, 256, nullptr, nullptr, nullptr, 0);
        k_gate0<<<(R * 1024) / 256, 256, 0, st>>>(y, P0, (const float*)d_in[4], (const float*)d_in[5], R);
        gemm(y, 1024, (const float*)d_in[6], 1024, h1, 1024, R, 1024, 1024, nullptr, nullptr, x, 1024);
        k_rstd<<<R / 4, 256, 0, st>>>(h1, rstd, R);
        gemm(h1, 1024, (const float*)d_in[7], 3088, proj, 3088, R, 3088, 1024, rstd, norm_w + 1024, nullptr, 0);
        k_cum<<<((R / 64) * 512) / 256, 256, 0, st>>>(proj, (const float*)d_in[8], (const float*)d_in[9], cum, R / 64);
        k_prep<<<(R * 512) / 256, 256, 0, st>>>(proj, cum, qp, qn, kp, kn, kd, decay, R);
        k_scores<<<(R / 64) * 4, 256, 0, st>>>(qp, qn, kp, kn, scores);
        k_gla_seq<<<64, 256, 0, st>>>(qp, kd, scores, decay, proj, o, R / 64);
        (void)hipMemcpyAsync(y2, o, (size_t)R * 1024 * 4, hipMemcpyDeviceToDevice, st);
        k_headnorm<<<R, 256, 0, st>>>(y2, proj, (const float*)d_in[10], R);
        gemm(y2, 1024, (const float*)d_in[11], 1024, h2, 1024, R, 1024, 1024, nullptr, nullptr, h1, 1024);
        (void)hipMemcpyAsync(outr, h2, (size_t)R * 1024 * 4, hipMemcpyDeviceToDevice, st);
        k_final<<<R / 4, 256, 0, st>>>(outr, (const float*)d_in[12], R);
    }
    unsigned* slots = (unsigned*)(ws + WS_CTL) + 2048;
    auto cmp = [&](const void* fast, int is_bf16, int mode, long fs, long fo, const float* refp, long rs, long ro, int rows, int cols, int tr, int slot) {
        dbg::k_cmp<<<(unsigned)(((long)rows * cols + 255) / 256), 256, 0, st>>>(fast, is_bf16, mode, fs, fo, refp, rs, ro, rows, cols, tr, slots, slot); };
    auto run = [&](int lo, int hi, int li) { a.ph_lo = lo; a.ph_hi = hi; a.li = li; hipLaunchKernelGGL(mk_fwd, dim3(grid), dim3(NTHR), LDS_BYTES, st, a); };
#if DBG == 1
    run(0, 1, 0); run(1, 2, 0);
    cmp(ws + WS_US, 1, 0, 2048, 0, P0, 2048, 0, R, 1024, 0, 1);
    cmp(ws + WS_US, 1, 0, 2048, 1024, P0, 2048, 1024, R, 1024, 1, 2);
    run(2, 3, 0); cmp(ws + WS_POOLED, 1, 0, 1024, 0, pooled, 1024, 0, R, 1024, 0, 3);
    run(3, 4, 0); cmp(ws + WS_Y, 1, 0, 1024, 0, y, 1024, 0, R, 1024, 0, 4);
    run(4, 5, 0); cmp(d_out, 0, 0, 1024, 0, h1, 1024, 0, R, 1024, 0, 5); cmp(ws + WS_H1B, 1, 0, 1024, 0, h1, 1024, 0, R, 1024, 0, 6);
    run(5, 6, 0);
    cmp(ws + WS_QKVG, 1, 0, 3072, 0, proj, 3088, 0, R, 512, 2, 7);
    cmp(ws + WS_QKVG, 1, 0, 3072, 512, proj, 3088, 512, R, 1536, 0, 8);
    cmp(ws + WS_QKVG, 1, 0, 3072, 2048, proj, 3088, 2048, R, 1024, 1, 9);
    cmp(ws + WS_GKL, 0, 0, 16, 0, proj, 3088, 3072, R, 16, 0, 10);
    run(6, 7, 0); run(7, 8, 0);
    run(8, 9, 0); cmp(ws + WS_Y2, 1, 0, 1024, 0, y2, 1024, 0, R, 1024, 0, 16);
    run(9, 10, 0); cmp(d_out, 0, 0, 1024, 0, h2, 1024, 0, R, 1024, 0, 17);
    run(10, 11, 0); cmp(d_out, 0, 0, 1024, 0, outr, 1024, 0, R, 1024, 0, 18);
#else
    run(0, NPH, 0);
    cmp(ws + WS_Y2, 1, 0, 1024, 0, y2, 1024, 0, R, 1024, 0, 16);
    cmp(d_out, 0, 0, 1024, 0, outr, 1024, 0, R, 1024, 0, 18);
#endif
    dbg::k_encode<<<(unsigned)(((long)M * D + 255) / 256), 256, 0, st>>>((float*)d_out, (long)M * D, slots, 19, DBG_ONLY);
#endif
}
```

```cpp
#include <hip/hip_runtime.h>
#include <cstdio>
#include <cstdint>
#define DBG 0
#define DBG_ONLY 0
#define PROBE_PHASE (-1)
namespace pg8 {
#define PG8_LAS __attribute__((address_space(3)))
typedef unsigned short bf16_t;
typedef short bf16x8 __attribute__((ext_vector_type(8)));
typedef float f32x4 __attribute__((ext_vector_type(4)));
typedef float f32x2 __attribute__((ext_vector_type(2)));
typedef unsigned u32x4 __attribute__((ext_vector_type(4)));
typedef unsigned u32x2 __attribute__((ext_vector_type(2)));
constexpr int BM = 256, BK = 64, HALF = 128, HTB = HALF * BK * 2, STAGE_BYTES = 8 * HTB, NXCD = 8, WGM = 8;

__host__ __device__ __forceinline__ int lds_byte(int r, int c) { const int st = (r >> 4) * 2 + (c >> 5), rr = r & 15, cc = c & 31, ob = rr * 64 + cc * 2; return st * 1024 + (ob ^ (((ob >> 9) & 1) << 5)); }
__host__ __device__ __forceinline__ void stage_rc(int b, int& R, int& C) { const int st = b / 1024, sb = b % 1024, swz = sb ^ (((sb >> 9) & 1) << 5); R = (st >> 1) * 16 + swz / 64; C = (st & 1) * 32 + (swz % 64) / 2; }
__host__ __device__ __forceinline__ int perm32(int rho) { const int n = rho >> 4, i = rho & 15; return 8 * (i >> 2) + 4 * n + (i & 3); }

struct Unit { int pm, pn; };
struct Gemm { const bf16_t* A; const bf16_t* Bt; int lda, ldb, K, apn; };

struct StaticOrder {
    int nM, nN, nwg, G, c;
    __host__ __device__ void init(int M, int N, int G_, int c_) { nM = M / BM; nN = N / BM; nwg = nM * nN; G = G_; c = c_; }
    __host__ __device__ bool next(int i, Unit& u) const {
        const long L = (long)i * G + c; if (L >= nwg) return false;
        int wgid = (int)L; { const int q = nwg / NXCD, r = nwg % NXCD, xcd = wgid % NXCD, off = wgid / NXCD; wgid = (xcd < r ? xcd * (q + 1) : r * (q + 1) + (xcd - r) * q) + off; }
        const int nig = WGM * nN, gid = wgid / nig, fm = gid * WGM, gsz = (nM - fm) < WGM ? (nM - fm) : WGM;
        u.pm = fm + ((wgid % nig) % gsz); u.pn = (wgid % nig) / gsz; return true;
    }
};

__device__ __forceinline__ unsigned cvt_pk_bf16(float lo, float hi) { unsigned r; asm volatile("v_cvt_pk_bf16_f32 %0, %1, %2" : "=v"(r) : "v"(lo), "v"(hi)); return r; }

template <class Epi, bool ALIGN_EPI>
__device__ __forceinline__ void gemm_phase(PG8_LAS unsigned char* lds, const Gemm g, const StaticOrder& S, const Epi& E) {
    int tid_ = threadIdx.x; asm volatile("" : "+v"(tid_));
    const int tid = tid_, wid = __builtin_amdgcn_readfirstlane(tid >> 6), lane = tid & 63, wr = wid >> 2, wc = wid & 3, fr = lane & 15, fq = lane >> 4;
    int K_ = g.K; asm volatile("" : "+s"(K_));
    const int K = K_, nt = K / BK;
    unsigned voffA[2], voffB[2];
#pragma unroll
    for (int i = 0; i < 2; ++i) { int R, C; stage_rc(tid * 16 + i * 8192, R, C); const int Rb = Epi::PERM ? ((R & ~31) + perm32(R & 31)) : R;
        voffA[i] = (unsigned)(R * g.lda + C) * 2u; voffB[i] = (unsigned)(Rb * g.ldb + C) * 2u; }
    const size_t kstep = (size_t)(BK * 2);
    const size_t hA = (size_t)HALF * g.lda * 2, hB = (size_t)HALF * g.ldb * 2;
    const unsigned ldsw = (unsigned)wid * 1024u;
    const int aoff = lds_byte(wr * 64 + fr, fq * 8), boff = lds_byte(wc * 32 + fr, fq * 8);
#define PG8_UA(u) ((const char*)g.A + ((size_t)(u).pm * 256 * g.lda + (size_t)(u).pn * g.apn) * 2)
#define PG8_UB(u) ((const char*)g.Bt + ((size_t)(u).pn * 256 * g.ldb) * 2)
#define PG8_SA(b, h) (((b) * 2 + (h)) * HTB)
#define PG8_SB(b, h) ((4 + (b) * 2 + (h)) * HTB)
#define PG8_STAGE(bufoff, gbase, voff) do { _Pragma("unroll") for (int _i = 0; _i < 2; ++_i) \
        __builtin_amdgcn_global_load_lds((const unsigned*)((const char*)(gbase) + (voff)[_i]), (PG8_LAS unsigned*)(lds + (bufoff) + ldsw + _i * 8192), 16, 0, 0); } while (0)
#define PG8_LDA(dst, b, h) do { _Pragma("unroll") for (int m = 0; m < 4; ++m) _Pragma("unroll") for (int k = 0; k < 2; ++k) dst[m][k] = *(const PG8_LAS bf16x8*)(lds + PG8_SA(b, h) + aoff + m * 2048 + k * 1024); } while (0)
#define PG8_LDB(dst, b, h) do { _Pragma("unroll") for (int n = 0; n < 2; ++n) _Pragma("unroll") for (int k = 0; k < 2; ++k) dst[n][k] = *(const PG8_LAS bf16x8*)(lds + PG8_SB(b, h) + boff + n * 2048 + k * 1024); } while (0)
#define PG8_MMA(ai, bj, At, Bt) do { __builtin_amdgcn_s_setprio(1); _Pragma("unroll") for (int m = 0; m < 4; ++m) _Pragma("unroll") for (int n = 0; n < 2; ++n) _Pragma("unroll") for (int k = 0; k < 2; ++k) \
        acc[ai][bj][m][n] = __builtin_amdgcn_mfma_f32_16x16x32_bf16(Bt[n][k], At[m][k], acc[ai][bj][m][n], 0, 0, 0); __builtin_amdgcn_s_setprio(0); } while (0)
#define PG8_WAIT_V(n) asm volatile("s_waitcnt vmcnt(" #n ")" ::: "memory")
#define PG8_WAIT_L(n) asm volatile("s_waitcnt lgkmcnt(" #n ")" ::: "memory")
#define PG8_BAR __builtin_amdgcn_s_barrier()
#define PG8_SCHED __builtin_amdgcn_sched_barrier(0)
    Unit cur, nxt; int ui = 0;
    if (!S.next(0, cur)) return;
    f32x4 acc[2][2][4][2];
#pragma unroll
    for (int a = 0; a < 2; ++a)
#pragma unroll
        for (int b = 0; b < 2; ++b)
#pragma unroll
            for (int m = 0; m < 4; ++m)
#pragma unroll
                for (int n = 0; n < 2; ++n) acc[a][b][m][n] = (f32x4){0.f, 0.f, 0.f, 0.f};
    bf16x8 At[4][2], B0[2][2], B1[2][2];
    const char* cA = PG8_UA(cur); const char* cB = PG8_UB(cur);
    PG8_STAGE(PG8_SB(0, 0), cB, voffB); PG8_STAGE(PG8_SB(0, 1), cB + hB, voffB); PG8_STAGE(PG8_SA(0, 0), cA, voffA); PG8_STAGE(PG8_SA(0, 1), cA + hA, voffA);
    if (wr == 1) PG8_BAR;
    PG8_WAIT_V(2); PG8_BAR;
    PG8_STAGE(PG8_SB(1, 0), cB + kstep, voffB); PG8_STAGE(PG8_SA(1, 0), cA + kstep, voffA); PG8_STAGE(PG8_SB(1, 1), cB + hB + kstep, voffB);
    PG8_WAIT_V(6); PG8_BAR;
    for (;;) {
        const bool has_next = S.next(ui + 1, nxt);
        const char* nA = has_next ? PG8_UA(nxt) : cA; const char* nB = has_next ? PG8_UB(nxt) : cB;
        for (int t = 0; t < nt; t += 2) {
            const bool last = (t == nt - 2);
            const char* a1 = cA + (size_t)(t + 1) * kstep;
            const char* a2 = last ? nA : cA + (size_t)(t + 2) * kstep; const char* b2 = last ? nB : cB + (size_t)(t + 2) * kstep;
            const char* a3 = a2 + kstep; const char* b3 = b2 + kstep;
            PG8_LDB(B0, 0, 0); PG8_LDB(B1, 0, 1); PG8_SCHED; PG8_LDA(At, 0, 0); PG8_STAGE(PG8_SA(1, 1), a1 + hA, voffA);
            PG8_WAIT_V(8); PG8_WAIT_L(0); PG8_BAR; PG8_MMA(0, 0, At, B0); PG8_MMA(0, 1, At, B1); PG8_BAR; PG8_SCHED;
            PG8_LDA(At, 0, 1); PG8_STAGE(PG8_SB(0, 0), b2, voffB); PG8_STAGE(PG8_SB(0, 1), b2 + hB, voffB); PG8_STAGE(PG8_SA(0, 0), a2, voffA);
            PG8_WAIT_V(8); PG8_WAIT_L(0); PG8_BAR; PG8_MMA(1, 0, At, B0); PG8_MMA(1, 1, At, B1); PG8_BAR; PG8_SCHED;
            PG8_LDB(B0, 1, 0); PG8_LDB(B1, 1, 1); PG8_SCHED; PG8_LDA(At, 1, 0); PG8_STAGE(PG8_SA(0, 1), a2 + hA, voffA);
            PG8_WAIT_V(8); PG8_WAIT_L(0); PG8_BAR; PG8_MMA(0, 0, At, B0); PG8_MMA(0, 1, At, B1); PG8_BAR; PG8_SCHED;
            PG8_LDA(At, 1, 1); PG8_STAGE(PG8_SB(1, 0), b3, voffB); PG8_STAGE(PG8_SB(1, 1), b3 + hB, voffB); PG8_STAGE(PG8_SA(1, 0), a3, voffA);
            PG8_WAIT_V(8); PG8_WAIT_L(0); PG8_BAR; PG8_MMA(1, 0, At, B0); PG8_MMA(1, 1, At, B1); PG8_BAR; PG8_SCHED;
        }
        if constexpr (ALIGN_EPI) { if (wr == 0) PG8_BAR; }
        if constexpr (!Epi::AFTER_DRAIN) { E(acc, cur, wr, wc, fr, fq); }
        if (!has_next) break;
#pragma unroll
        for (int a = 0; a < 2; ++a)
#pragma unroll
            for (int b = 0; b < 2; ++b)
#pragma unroll
                for (int m = 0; m < 4; ++m)
#pragma unroll
                    for (int n = 0; n < 2; ++n) acc[a][b][m][n] = (f32x4){0.f, 0.f, 0.f, 0.f};
        cur = nxt; cA = nA; cB = nB; ++ui;
        if constexpr (ALIGN_EPI) { if (wr == 1) PG8_BAR; }
    }
    PG8_WAIT_V(0);
    if constexpr (!ALIGN_EPI) { if (wr == 0) PG8_BAR; }
    PG8_BAR;
    if constexpr (Epi::AFTER_DRAIN) { E.fused(acc, cur, wr, wc, fr, fq, lds, wid, lane); }
#undef PG8_UA
#undef PG8_UB
#undef PG8_SA
#undef PG8_SB
#undef PG8_STAGE
#undef PG8_LDA
#undef PG8_LDB
#undef PG8_MMA
#undef PG8_WAIT_V
#undef PG8_WAIT_L
#undef PG8_BAR
#undef PG8_SCHED
}
}
constexpr int NWAVES = 8, NTHR = NWAVES * 64;
constexpr int D = 1024, SEQ = 4096, BATCH = 4, M = BATCH * SEQ;
constexpr int CHUNK = 64, NCH = SEQ / CHUNK;
constexpr int GIN = 3088, NQKVG = 3072;
constexpr float EPS = 1e-6f;
constexpr int NPH = 11;

constexpr size_t MiB = 1u << 20;
constexpr size_t WS_CTL = 0, CTL_ZERO_BYTES = 1 * MiB;
constexpr size_t WS_W1T = 1 * MiB, WS_GWT = 5 * MiB, WS_W3T = 6 * MiB, WS_W4T = 8 * MiB, WS_W6T = 15 * MiB;
constexpr size_t WS_RSTD0 = 17 * MiB, WS_SSQ1 = 17 * MiB + 64 * 1024, WS_SSQ2 = 17 * MiB + 320 * 1024;
constexpr size_t WS_GKL = 18 * MiB, WS_DSEG = 19 * MiB;
constexpr size_t WS_XB = 24 * MiB, WS_US = 56 * MiB, WS_QKVG = 24 * MiB;
constexpr size_t WS_POOLED = 120 * MiB, WS_FS = 120 * MiB;
constexpr size_t WS_Y = 152 * MiB, WS_GS = 152 * MiB;
constexpr size_t WS_H1B = 184 * MiB, WS_Y2 = 184 * MiB;
constexpr size_t WS_DBG = 216 * MiB, WS_END = 256 * MiB;
constexpr int CW_BAR = 4096, N_BAR_REGIONS = 12;

constexpr int RING_BYTES = 131072, LDS_BYTES = 159744, LDSCTL_OFF = LDS_BYTES - 1024, MISC_OFF = LDSCTL_OFF + 320;

#define GAS __attribute__((address_space(1)))
#define LAS __attribute__((address_space(3)))
typedef unsigned short bf16;
typedef unsigned v4u __attribute__((ext_vector_type(4)));
typedef unsigned v2u __attribute__((ext_vector_type(2)));
typedef float f32x4 __attribute__((ext_vector_type(4)));
typedef short bf16x8 __attribute__((ext_vector_type(8)));
typedef GAS unsigned gu32;
#define RLX_AGENT __ATOMIC_RELAXED, __HIP_MEMORY_SCOPE_AGENT
#define LDS_WAIT() asm volatile("s_waitcnt lgkmcnt(0)" ::: "memory")
#define VM_WAIT() asm volatile("s_waitcnt vmcnt(0)" ::: "memory")
__device__ __forceinline__ unsigned f2bf(float f) { unsigned u = __builtin_bit_cast(unsigned, f); return (u + 0x7fffu + ((u >> 16) & 1u)) >> 16; }
__device__ __forceinline__ unsigned pk2(float lo, float hi) { return f2bf(lo) | (f2bf(hi) << 16); }
__device__ __forceinline__ float bf2f(unsigned h) { return __builtin_bit_cast(float, h << 16); }
__device__ __forceinline__ float bflo(unsigned w) { return __builtin_bit_cast(float, w << 16); }
__device__ __forceinline__ float bfhi(unsigned w) { return __builtin_bit_cast(float, w & 0xffff0000u); }
__device__ __forceinline__ float fsilu(float v) { return v * __builtin_amdgcn_rcpf(1.f + __builtin_amdgcn_exp2f(-1.4426950408889634f * v)); }
__device__ __forceinline__ float wave_sum(float v) {
#pragma unroll
    for (int o = 1; o < 64; o <<= 1) v += __shfl_xor(v, o);
    return v;
}

#define XB_TMO      128
#define XB_XCNT(j)  (256  + 64 * (j))
#define XB_XSUB(j)  (1280 + 64 * (j))
#define XB_XGEN(j)  (2304 + 64 * (j))
#define XB_TOP      3328
#define XB_TOPGEN   3392
#define XCD_BAR_WORDS 3456
#define XB_SPIN_CAP (1u << 18)
__device__ __forceinline__ unsigned xb_ld(unsigned* p)              { return __hip_atomic_load(p, __ATOMIC_RELAXED, __HIP_MEMORY_SCOPE_AGENT); }
__device__ __forceinline__ unsigned xb_add(unsigned* p, unsigned v) { return __hip_atomic_fetch_add(p, v, __ATOMIC_RELAXED, __HIP_MEMORY_SCOPE_AGENT); }
__device__ __forceinline__ unsigned xb_xcc_id() { return (unsigned)__builtin_amdgcn_s_getreg((3 << 11) | 20) & 0xFu; }
#define XB_SPIN(cond, bar) do { unsigned _sp = 0; while (cond) { __builtin_amdgcn_s_sleep(1); \
    if ((++_sp & 255u) == 0u) { if (xb_ld(&(bar)[XB_TMO])) break; if (_sp > XB_SPIN_CAP) { atomicAdd(&(bar)[XB_TMO], 1u); break; } } } } while (0)
struct XcdBarrier { unsigned* bar; unsigned x; volatile LAS unsigned* st; };
__device__ __forceinline__ XcdBarrier xcd_barrier_post(unsigned* bar, volatile LAS unsigned* st) {
    XcdBarrier b; b.bar = bar; b.x = xb_xcc_id(); b.st = st;
    if (threadIdx.x == 0) (void)xb_add(&bar[XB_XCNT(b.x)], 1u);
    return b;
}
__device__ __forceinline__ void xcd_barrier_complete(unsigned* bar, unsigned x, unsigned& nloc, unsigned& nx) {
    const unsigned G = gridDim.x * gridDim.y * gridDim.z;
    unsigned sum, cnt, mine, sp = 0u;
    for (;;) {
        sum = 0u; cnt = 0u; mine = 0u;
#pragma unroll
        for (unsigned j = 0; j < 16; ++j) { const unsigned c = xb_ld(&bar[XB_XCNT(j)]); sum += c; cnt += (c > 0u) ? 1u : 0u; mine = (j == x) ? c : mine; }
        if (sum == G) break;
        __builtin_amdgcn_s_sleep(1);
        if ((++sp & 255u) == 0u) { if (xb_ld(&bar[XB_TMO])) break; if (sp > XB_SPIN_CAP) { atomicAdd(&bar[XB_TMO], 1u); break; } }
    }
    nloc = mine > 0u ? mine : 1u; nx = cnt > 0u ? cnt : 1u;
}
__device__ __forceinline__ void xcd_barrier(const XcdBarrier& b) {
    asm volatile("s_waitcnt vmcnt(0)" ::: "memory");
    __syncthreads();
    if (threadIdx.x == 0) {
        unsigned* bar = b.bar;
        __builtin_amdgcn_s_waitcnt(0);
        unsigned nloc = b.st[0], nx = b.st[1];
        if (nloc == 0u) { xcd_barrier_complete(bar, b.x, nloc, nx); b.st[0] = nloc; b.st[1] = nx; }
        const unsigned old = xb_add(&bar[XB_XSUB(b.x)], 1u);
        const unsigned gen = old / nloc;
        if (old + 1u == (gen + 1u) * nloc) {
            __builtin_amdgcn_fence(__ATOMIC_RELEASE, "agent");
            asm volatile("s_waitcnt vmcnt(0)" ::: "memory");
            const unsigned og = xb_add(&bar[XB_TOP], 1u);
            const unsigned tg = og / nx;
            if (og + 1u == (tg + 1u) * nx) xb_add(&bar[XB_TOPGEN], 1u);
            else XB_SPIN(xb_ld(&bar[XB_TOPGEN]) == tg, bar);
            __builtin_amdgcn_fence(__ATOMIC_ACQUIRE, "agent");
            xb_add(&bar[XB_XGEN(b.x)], 1u);
            asm volatile("s_waitcnt vmcnt(0)" ::: "memory");
        } else {
            XB_SPIN(xb_ld(&bar[XB_XGEN(b.x)]) == gen, bar);
            __builtin_amdgcn_fence(__ATOMIC_ACQUIRE, "agent");
            asm volatile("s_waitcnt vmcnt(0)" ::: "memory");
        }
    }
    __syncthreads();
}

struct Frame {
    LAS unsigned char* lds;
    int tid, lane, wave, vcu, G;
    unsigned char* ws;
    const float* in[13];
    float* out;
};
using pg8::Unit;
struct Epi1 {
    static constexpr bool PERM = true, AFTER_DRAIN = false;
    bf16* US; const float* rstd0;
    __device__ __forceinline__ void operator()(const f32x4 (&acc)[2][2][4][2], const Unit& u, int wr, int wc, int fr, int fq) const {
        const int row0 = u.pm * 256 + wr * 64 + fr, col0 = u.pn * 256 + wc * 32 + 8 * fq; const bool gate = u.pn >= 4;
#pragma unroll
        for (int ai = 0; ai < 2; ++ai)
#pragma unroll
            for (int m = 0; m < 4; ++m) { const int row = row0 + ai * 128 + m * 16; const float rs = rstd0[row]; bf16* rowp = US + (size_t)row * 2048 + col0;
#pragma unroll
                for (int bj = 0; bj < 2; ++bj) { f32x4 v0 = acc[ai][bj][m][0] * rs, v1 = acc[ai][bj][m][1] * rs;
                    if (gate) {
#pragma unroll
                        for (int e = 0; e < 4; ++e) { v0[e] = fsilu(v0[e]); v1[e] = fsilu(v1[e]); } }
                    v4u w; w.x = pg8::cvt_pk_bf16(v0[0], v0[1]); w.y = pg8::cvt_pk_bf16(v0[2], v0[3]); w.z = pg8::cvt_pk_bf16(v1[0], v1[1]); w.w = pg8::cvt_pk_bf16(v1[2], v1[3]);
                    *(v4u*)(rowp + bj * 128) = w; } }
    }
};
struct Epi2 {
    static constexpr bool PERM = true, AFTER_DRAIN = false;
    bf16* Y; const bf16* US; const float* gb; const float* sc;
    __device__ __forceinline__ void operator()(const f32x4 (&acc)[2][2][4][2], const Unit& u, int wr, int wc, int fr, int fq) const {
        const int row0 = u.pm * 256 + wr * 64 + fr, col0 = u.pn * 256 + wc * 32 + 8 * fq;
        f32x4 bv[2][2], sv[2][2];
#pragma unroll
        for (int bj = 0; bj < 2; ++bj)
#pragma unroll
            for (int n = 0; n < 2; ++n) { bv[bj][n] = *(const f32x4*)(gb + col0 + bj * 128 + 4 * n); sv[bj][n] = *(const f32x4*)(sc + col0 + bj * 128 + 4 * n); }
#pragma unroll
        for (int ai = 0; ai < 2; ++ai)
#pragma unroll
            for (int m = 0; m < 4; ++m) { const int row = row0 + ai * 128 + m * 16;
#pragma unroll
                for (int bj = 0; bj < 2; ++bj) { const v4u g = *(const v4u*)(US + (size_t)row * 2048 + 1024 + col0 + bj * 128);
                    f32x4 v0 = (acc[ai][bj][m][0] + bv[bj][0]) * sv[bj][0], v1 = (acc[ai][bj][m][1] + bv[bj][1]) * sv[bj][1];
                    v0[0] *= bflo(g.x); v0[1] *= bfhi(g.x); v0[2] *= bflo(g.y); v0[3] *= bfhi(g.y); v1[0] *= bflo(g.z); v1[1] *= bfhi(g.z); v1[2] *= bflo(g.w); v1[3] *= bfhi(g.w);
                    v4u w; w.x = pg8::cvt_pk_bf16(v0[0], v0[1]); w.y = pg8::cvt_pk_bf16(v0[2], v0[3]); w.z = pg8::cvt_pk_bf16(v1[0], v1[1]); w.w = pg8::cvt_pk_bf16(v1[2], v1[3]);
                    *(v4u*)(Y + (size_t)row * 1024 + col0 + bj * 128) = w; } }
    }
};
template <bool WB> struct EpiRes {
    static constexpr bool PERM = false, AFTER_DRAIN = true;
    const float* base; float* out; bf16* hb; float* ssq;
    __device__ __forceinline__ void fused(f32x4 (&acc)[2][2][4][2], const Unit& u, int wr, int wc, int fr, int fq, PG8_LAS unsigned char* lds, int wid, int lane) const {
        PG8_LAS float* P = (PG8_LAS float*)lds;
        const int col0 = u.pn * 256 + wc * 32 + 4 * fq;
#pragma unroll
        for (int ai = 0; ai < 2; ++ai)
#pragma unroll
            for (int m = 0; m < 4; ++m) { const int rl = ai * 128 + wr * 64 + m * 16 + fr; const size_t off = (size_t)(u.pm * 256 + rl) * 1024 + col0; float s = 0.f;
#pragma unroll
                for (int bj = 0; bj < 2; ++bj)
#pragma unroll
                    for (int n = 0; n < 2; ++n) { const f32x4 h = *(const f32x4*)(base + off + bj * 128 + n * 16) + acc[ai][bj][m][n];
                        *(f32x4*)(out + off + bj * 128 + n * 16) = h;
                        if (WB) { v2u w; w.x = pg8::cvt_pk_bf16(h[0], h[1]); w.y = pg8::cvt_pk_bf16(h[2], h[3]); *(v2u*)(hb + off + bj * 128 + n * 16) = w; }
                        s += (h[0] * h[0] + h[1] * h[1]) + (h[2] * h[2] + h[3] * h[3]); }
                s += __shfl_xor(s, 16); s += __shfl_xor(s, 32);
                if (fq == 0) P[rl * 4 + wc] = s; }
        asm volatile("s_waitcnt lgkmcnt(0)" ::: "memory"); __builtin_amdgcn_s_barrier(); asm volatile("" ::: "memory");
        const int tid = wid * 64 + lane;
        if (tid < 256) { const float s = (P[tid * 4 + 0] + P[tid * 4 + 1]) + (P[tid * 4 + 2] + P[tid * 4 + 3]); ssq[(size_t)u.pn * M + u.pm * 256 + tid] = s; }
        asm volatile("s_waitcnt lgkmcnt(0)" ::: "memory"); __builtin_amdgcn_s_barrier(); asm volatile("" ::: "memory");
    }
};
__device__ __forceinline__ float rstd_from4(const float* ssq, int row) {
    const float s = (ssq[row] + ssq[M + row]) + (ssq[2 * M + row] + ssq[3 * M + row]);
    return __builtin_amdgcn_rsqf(s * (1.f / 1024.f) + EPS);
}
struct Epi4 {
    static constexpr bool PERM = true, AFTER_DRAIN = false;
    bf16* O; const float* ssq1;
    __device__ __forceinline__ void operator()(const f32x4 (&acc)[2][2][4][2], const Unit& u, int wr, int wc, int fr, int fq) const {
        const int row0 = u.pm * 256 + wr * 64 + fr, col0 = u.pn * 256 + wc * 32 + 8 * fq; const bool gate = u.pn >= 8; const float qs = u.pn < 2 ? 0.08838834764831845f : 1.f;
#pragma unroll
        for (int ai = 0; ai < 2; ++ai)
#pragma unroll
            for (int m = 0; m < 4; ++m) { const int row = row0 + ai * 128 + m * 16; const float rs = rstd_from4(ssq1, row) * qs; bf16* rowp = O + (size_t)row * NQKVG + col0;
#pragma unroll
                for (int bj = 0; bj < 2; ++bj) { f32x4 v0 = acc[ai][bj][m][0] * rs, v1 = acc[ai][bj][m][1] * rs;
                    if (gate) {
#pragma unroll
                        for (int e = 0; e < 4; ++e) { v0[e] = fsilu(v0[e]); v1[e] = fsilu(v1[e]); } }
                    v4u w; w.x = pg8::cvt_pk_bf16(v0[0], v0[1]); w.y = pg8::cvt_pk_bf16(v0[2], v0[3]); w.z = pg8::cvt_pk_bf16(v1[0], v1[1]); w.w = pg8::cvt_pk_bf16(v1[2], v1[3]);
                    *(v4u*)(rowp + bj * 128) = w; } }
    }
};

#define PHASE_IDS() int tid_ = F.tid; asm volatile("" : "+v"(tid_)); const int tid = tid_, lane = tid & 63; (void)lane
__device__ __forceinline__ void p0_transpose_item(const float* W, int K, int N, const float* ks, bf16* WT, LAS float* scr, int item, int lane) {
    const int nblk = (N + 31) / 32, kb = item / nblk, nb = item % nblk, k0 = 64 * kb, n0 = 32 * nb;
    const int n_in = n0 + (lane & 31);
#pragma unroll 8
    for (int i = 0; i < 32; ++i) { const int kk = 2 * i + (lane >> 5); float v = (n_in < N) ? W[(size_t)(k0 + kk) * N + n_in] : 0.f; if (ks) v *= ks[k0 + kk]; scr[kk * 33 + (lane & 31)] = v; }
    LDS_WAIT(); asm volatile("" ::: "memory");
    const int c = lane & 7;
#pragma unroll
    for (int j = 0; j < 4; ++j) { const int n = (lane >> 3) + 8 * j; const LAS float* s = scr + (8 * c) * 33 + n;
        v4u o; o.x = pk2(s[0 * 33], s[1 * 33]); o.y = pk2(s[2 * 33], s[3 * 33]); o.z = pk2(s[4 * 33], s[5 * 33]); o.w = pk2(s[6 * 33], s[7 * 33]);
        *(GAS v4u*)(WT + (size_t)(n0 + n) * K + k0 + 8 * c) = o; }
    LDS_WAIT(); asm volatile("" ::: "memory");
}
__device__ __forceinline__ void phase_prep(Frame& F) {
    PHASE_IDS();
    LAS float* scr = (LAS float*)(F.lds + F.wave * 16384);
    const int gw = F.vcu * NWAVES + F.wave, NGW = F.G * NWAVES;
    constexpr int I1 = 16 * 64, IG = 4 * 8, I3 = 16 * 32, I4 = 16 * 97, I6 = 16 * 32;
    constexpr int NITEMS = I1 + 4 * IG + I3 + I4 + I6;
    const float* nw = F.in[1];
    for (int it = gw; it < NITEMS; it += NGW) {
        int r = it;
        if (r < I1) { p0_transpose_item(F.in[2], 1024, 2048, nw, (bf16*)(F.ws + WS_W1T), scr, r, lane); continue; } r -= I1;
        if (r < 4 * IG) { const int g = r / IG; p0_transpose_item(F.in[3] + (size_t)g * 65536, 256, 256, nullptr, (bf16*)(F.ws + WS_GWT) + (size_t)g * 65536, scr, r % IG, lane); continue; } r -= 4 * IG;
        if (r < I3) { p0_transpose_item(F.in[6], 1024, 1024, nullptr, (bf16*)(F.ws + WS_W3T), scr, r, lane); continue; } r -= I3;
        if (r < I4) { p0_transpose_item(F.in[7], 1024, GIN, nw + 1024, (bf16*)(F.ws + WS_W4T), scr, r, lane); continue; } r -= I4;
        p0_transpose_item(F.in[11], 1024, 1024, nullptr, (bf16*)(F.ws + WS_W6T), scr, r, lane);
    }
    const float* x = F.in[0]; bf16* XB = (bf16*)(F.ws + WS_XB); float* rstd0 = (float*)(F.ws + WS_RSTD0);
    for (int m = gw; m < M; m += NGW) {
        const GAS f32x4* xr = (const GAS f32x4*)(x + (size_t)m * D) + lane;
        f32x4 v[4]; float s = 0.f;
#pragma unroll
        for (int j = 0; j < 4; ++j) { v[j] = xr[64 * j]; s += (v[j].x * v[j].x + v[j].y * v[j].y) + (v[j].z * v[j].z + v[j].w * v[j].w); }
        s = wave_sum(s);
        if (lane == 0) rstd0[m] = __builtin_amdgcn_rsqf(s * (1.f / D) + EPS);
        GAS v2u* o8 = (GAS v2u*)(XB + (size_t)m * D) + lane;
#pragma unroll
        for (int j = 0; j < 4; ++j) { v2u w; w.x = pk2(v[j].x, v[j].y); w.y = pk2(v[j].z, v[j].w); o8[64 * j] = w; }
    }
}
__device__ __forceinline__ void unpack8(const v4u w, float (&f)[8]) { f[0] = bflo(w.x); f[1] = bfhi(w.x); f[2] = bflo(w.y); f[3] = bfhi(w.y); f[4] = bflo(w.z); f[5] = bfhi(w.z); f[6] = bflo(w.w); f[7] = bfhi(w.w); }
__device__ __forceinline__ void phase_pool(Frame& F) {
    PHASE_IDS();
    const bf16* US = (const bf16*)(F.ws + WS_US); bf16* PO = (bf16*)(F.ws + WS_POOLED);
    for (int gid = F.vcu * NTHR + tid; gid < 1024 * 128; gid += F.G * NTHR) {
        const int c8 = gid & 127, run = gid >> 7, t0 = run * 16, pos0 = t0 & (SEQ - 1), w = 2 << (c8 >> 5);
        const bf16* up = US + (size_t)t0 * 2048 + c8 * 8;
        float s[8], f[8];
#pragma unroll
        for (int e = 0; e < 8; ++e) s[e] = 0.f;
        if (pos0 > 0) for (int i = 1; i < w; ++i) { unpack8(*(const v4u*)(up - (size_t)i * 2048), f);
#pragma unroll
            for (int e = 0; e < 8; ++e) s[e] += f[e]; }
#pragma unroll 4
        for (int j = 0; j < 16; ++j) {
            unpack8(*(const v4u*)(up + (size_t)j * 2048), f);
            const int p1 = pos0 + j + 1; const float inv = 1.f / (float)(p1 < w ? p1 : w);
#pragma unroll
            for (int e = 0; e < 8; ++e) s[e] += f[e];
            v4u o; o.x = pk2(s[0] * inv - f[0], s[1] * inv - f[1]); o.y = pk2(s[2] * inv - f[2], s[3] * inv - f[3]); o.z = pk2(s[4] * inv - f[4], s[5] * inv - f[5]); o.w = pk2(s[6] * inv - f[6], s[7] * inv - f[7]);
            *(v4u*)(PO + (size_t)(t0 + j) * 1024 + c8 * 8) = o;
            if (p1 >= w) { unpack8(*(const v4u*)(up + (ptrdiff_t)(j + 1 - w) * 2048), f);
#pragma unroll
                for (int e = 0; e < 8; ++e) s[e] -= f[e]; }
        }
    }
}
__device__ __forceinline__ void phase_gklow(Frame& F) {
    PHASE_IDS();
    const bf16* H1B = (const bf16*)(F.ws + WS_H1B); const bf16* W4T = (const bf16*)(F.ws + WS_W4T); const float* ssq1 = (const float*)(F.ws + WS_SSQ1); float* GKL = (float*)(F.ws + WS_GKL);
    if (F.wave < 4) for (int item = F.vcu; item < M / 64; item += F.G) {
        const int r0 = item * 64 + F.wave * 16, l15 = lane & 15, lq = lane >> 4;
        const bf16* ap = H1B + (size_t)(r0 + l15) * 1024 + lq * 8; const bf16* bp = W4T + (size_t)(3072 + l15) * 1024 + lq * 8;
        f32x4 acc = (f32x4){0.f, 0.f, 0.f, 0.f};
#pragma unroll 8
        for (int kk = 0; kk < 32; ++kk) { const bf16x8 a = *(const bf16x8*)(ap + kk * 32), b = *(const bf16x8*)(bp + kk * 32); acc = __builtin_amdgcn_mfma_f32_16x16x32_bf16(a, b, acc, 0, 0, 0); }
#pragma unroll
        for (int r = 0; r < 4; ++r) { const int row = r0 + 4 * lq + r; GKL[(size_t)row * 16 + l15] = acc[r] * rstd_from4(ssq1, row); }
    }
}
typedef short s16x4 __attribute__((ext_vector_type(4)));
typedef float f32x2 __attribute__((ext_vector_type(2)));
constexpr int C_QPS = 0, C_QNS = 17408, C_KPS = 34816, C_KNS = 52224, C_ROW = 272;
constexpr int C_KD = 69632, C_KDROW = 288;
constexpr int C_V = 88064, C_VROW = 544;
constexpr int C_SC = 122880, C_SCROW = 144;
constexpr int C_GL = 132096, C_TOT = 136192, C_DEC = 140288, C_NRM = 140800, C_W = 142848, C_END = 151040;
static_assert(C_END <= LDSCTL_OFF, "GLA LDS map");
#define LBAR() do { asm volatile("s_waitcnt lgkmcnt(0)" ::: "memory"); __builtin_amdgcn_s_barrier(); asm volatile("" ::: "memory"); } while (0)
__device__ __forceinline__ s16x4 ds_tr(const LAS unsigned char* p) { return __builtin_bit_cast(s16x4, __builtin_amdgcn_ds_read_tr16_b64_v4i16((LAS s16x4*)p)); }
__device__ __forceinline__ bf16x8 tr_frag(const LAS unsigned char* img, int stride, int row0, int col0, int i, int q) {
    const LAS unsigned char* p = img + (row0 + 8 * q + (i >> 2)) * stride + (col0 + 4 * (i & 3)) * 2;
    const s16x4 a = ds_tr(p), b = ds_tr(p + 4 * stride);
    return (bf16x8){a[0], a[1], a[2], a[3], b[0], b[1], b[2], b[3]};
}
struct ChunkRegs { unsigned qv[8], kv[8]; v4u vt[4]; f32x4 gl; };
template <bool FULL> __device__ __forceinline__ void chunk_load(Frame& F, int tid, int t0, int h, ChunkRegs& R) {
    const bf16* QKVG = (const bf16*)(F.ws + WS_QKVG); const float* GKL = (const float*)(F.ws + WS_GKL);
    const int kp = tid & 63, tg = tid >> 6;
    const bf16* qb = QKVG + (size_t)(t0 + tg * 8) * NQKVG + h * 128 + 2 * kp;
#pragma unroll
    for (int j = 0; j < 8; ++j) { R.kv[j] = *(const unsigned*)(qb + (size_t)j * NQKVG + 512); if (FULL) R.qv[j] = *(const unsigned*)(qb + (size_t)j * NQKVG); }
#pragma unroll
    for (int i = 0; i < 4; ++i) { const int idx = tid + i * NTHR, row = idx >> 5, c16 = idx & 31; R.vt[i] = *(const v4u*)(QKVG + (size_t)(t0 + row) * NQKVG + 1024 + h * 256 + c16 * 8); }
    if (tid < 256) R.gl = ((const f32x4*)(GKL + (size_t)t0 * 16))[tid];
}
template <bool FULL> __device__ __forceinline__ f32x2 chunk_elem(Frame& F, int tid, const ChunkRegs& R, f32x2 bb) {
    LAS unsigned char* lds = F.lds;
    const int kp = tid & 63, tg = tid >> 6;
    if (tid < 256) ((LAS f32x4*)(lds + C_GL))[tid] = R.gl;
#pragma unroll
    for (int i = 0; i < 4; ++i) { const int idx = tid + i * NTHR, row = idx >> 5, c16 = idx & 31; *(LAS v4u*)(lds + C_V + row * C_VROW + c16 * 16) = R.vt[i]; }
    LBAR();
    f32x2 c[8];
#pragma unroll
    for (int j = 0; j < 8; ++j) c[j] = bb;
#pragma unroll
    for (int r4 = 0; r4 < 4; ++r4) { f32x2 w[4];
#pragma unroll
        for (int r = 0; r < 4; ++r) w[r] = *(const LAS f32x2*)(lds + C_W + ((4 * r4 + r) * 128 + 2 * kp) * 4);
#pragma unroll
        for (int j = 0; j < 8; ++j) { const f32x4 g = *(const LAS f32x4*)(lds + C_GL + (tg * 8 + j) * 64 + r4 * 16); c[j] += w[0] * g[0]; c[j] += w[1] * g[1]; c[j] += w[2] * g[2]; c[j] += w[3] * g[3]; } }
    f32x2 run = (f32x2){0.f, 0.f};
#pragma unroll
    for (int j = 0; j < 8; ++j) { const f32x2 z = c[j];
        f32x2 ls; ls.x = fminf(z.x, 0.f) - __logf(1.f + __expf(-fabsf(z.x))); ls.y = fminf(z.y, 0.f) - __logf(1.f + __expf(-fabsf(z.y)));
        run += ls * (1.f / 16.f); c[j] = run; }
    *(LAS f32x2*)(lds + C_TOT + (tg * 128 + 2 * kp) * 4) = run;
    LBAR();
    f32x2 pre = (f32x2){0.f, 0.f}, cl = (f32x2){0.f, 0.f};
#pragma unroll
    for (int g = 0; g < 8; ++g) { const f32x2 tt = *(const LAS f32x2*)(lds + C_TOT + (g * 128 + 2 * kp) * 4); if (g < tg) pre += tt; cl += tt; }
#pragma unroll
    for (int j = 0; j < 8; ++j) { const int t = tg * 8 + j; const f32x2 cum = pre + c[j]; const float k0 = bflo(R.kv[j]), k1 = bfhi(R.kv[j]);
        *(LAS unsigned*)(lds + C_KD + t * C_KDROW + kp * 4) = pg8::cvt_pk_bf16(k0 * __expf(cl.x - cum.x), k1 * __expf(cl.y - cum.y));
        if (FULL) { const float ep0 = __expf(cum.x), ep1 = __expf(cum.y), en0 = __expf(-cum.x), en1 = __expf(-cum.y), q0 = bflo(R.qv[j]), q1 = bfhi(R.qv[j]);
            *(LAS unsigned*)(lds + C_QPS + t * C_ROW + kp * 4) = pg8::cvt_pk_bf16(q0 * ep0, q1 * ep1);
            *(LAS unsigned*)(lds + C_QNS + t * C_ROW + kp * 4) = pg8::cvt_pk_bf16(q0 * en0, q1 * en1);
            *(LAS unsigned*)(lds + C_KPS + t * C_ROW + kp * 4) = pg8::cvt_pk_bf16(k0 * ep0, k1 * ep1);
            *(LAS unsigned*)(lds + C_KNS + t * C_ROW + kp * 4) = pg8::cvt_pk_bf16(k0 * en0, k1 * en1); } }
    if (tg == 0) *(LAS f32x2*)(lds + C_DEC + 2 * kp * 4) = (f32x2){__expf(cl.x), __expf(cl.y)};
    LBAR();
    return cl;
}
__device__ __forceinline__ void load_w_image(Frame& F, int tid, int h) {
    const int r = tid >> 5, c4 = (tid & 31) * 4;
    *(LAS f32x4*)(F.lds + C_W + (r * 128 + c4) * 4) = *(const f32x4*)(F.in[8] + r * 512 + h * 128 + c4);
}
__device__ __forceinline__ void phase_gla_a(Frame& F) {
    PHASE_IDS();
    LAS unsigned char* lds = F.lds;
    float* FS = (float*)(F.ws + WS_FS); float* DSEG = (float*)(F.ws + WS_DSEG);
    const int i15 = lane & 15, q = lane >> 4, wave = F.wave, kp = tid & 63;
    for (int unit = F.vcu; unit < 256; unit += F.G) {
        const int bh = unit >> 4, g = unit & 15, b = bh >> 2, h = bh & 3;
        if (g == 15) continue;
        const int tb = b * SEQ + g * 256;
        ChunkRegs R; chunk_load<false>(F, tid, tb, h, R);
        load_w_image(F, tid, h);
        const f32x2 bb = *(const f32x2*)(F.in[9] + h * 128 + 2 * kp);
        f32x4 S[8][2];
#pragma unroll
        for (int kt = 0; kt < 8; ++kt) { S[kt][0] = (f32x4){0.f, 0.f, 0.f, 0.f}; S[kt][1] = S[kt][0]; }
        f32x2 clsum = (f32x2){0.f, 0.f};
        LBAR();
        for (int c = 0; c < 4; ++c) {
            clsum += chunk_elem<false>(F, tid, R, bb);
            if (c < 3) chunk_load<false>(F, tid, tb + (c + 1) * 64, h, R);
#pragma unroll
            for (int kt = 0; kt < 8; ++kt) { const f32x4 d = *(const LAS f32x4*)(lds + C_DEC + (16 * kt + 4 * q) * 4); S[kt][0] *= d; S[kt][1] *= d; }
#pragma unroll
            for (int ts = 0; ts < 2; ++ts) {
                const bf16x8 v0 = tr_frag(lds + C_V, C_VROW, 32 * ts, 32 * wave, i15, q), v1 = tr_frag(lds + C_V, C_VROW, 32 * ts, 32 * wave + 16, i15, q);
#pragma unroll
                for (int kt = 0; kt < 8; ++kt) { const bf16x8 a = tr_frag(lds + C_KD, C_KDROW, 32 * ts, 16 * kt, i15, q);
                    S[kt][0] = __builtin_amdgcn_mfma_f32_16x16x32_bf16(a, v0, S[kt][0], 0, 0, 0); S[kt][1] = __builtin_amdgcn_mfma_f32_16x16x32_bf16(a, v1, S[kt][1], 0, 0, 0); } }
            LBAR();
        }
        f32x4* fo = (f32x4*)FS + ((size_t)(unit * 8 + wave) * 16) * 64 + lane;
#pragma unroll
        for (int kt = 0; kt < 8; ++kt) { fo[(kt * 2 + 0) * 64] = S[kt][0]; fo[(kt * 2 + 1) * 64] = S[kt][1]; }
        if (tid < 64) *(f32x2*)(DSEG + unit * 128 + 2 * kp) = (f32x2){__expf(clsum.x), __expf(clsum.y)};
    }
}
__device__ __forceinline__ void phase_gla_b(Frame& F) {
    PHASE_IDS();
    const f32x4* FS = (const f32x4*)(F.ws + WS_FS); f32x4* GS = (f32x4*)(F.ws + WS_GS); const float* DSEG = (const float*)(F.ws + WS_DSEG);
    for (int T = F.vcu * NTHR + tid; T < 16 * 8192; T += F.G * NTHR) {
        const int bh = T >> 13, rem = T & 8191, tile = (rem >> 6) & 15, ln = rem & 63, kt = tile >> 1, q = ln >> 4;
        f32x4 f[15], d[15];
#pragma unroll
        for (int g = 0; g < 15; ++g) { f[g] = FS[(size_t)(bh * 16 + g) * 8192 + rem]; d[g] = *(const f32x4*)(DSEG + (bh * 16 + g) * 128 + 16 * kt + 4 * q); }
        f32x4 G = (f32x4){0.f, 0.f, 0.f, 0.f};
#pragma unroll
        for (int g = 0; g < 15; ++g) { G = G * d[g] + f[g]; GS[(size_t)(bh * 16 + g + 1) * 8192 + rem] = G; }
    }
}
__device__ __forceinline__ void phase_gla_c(Frame& F) {
    PHASE_IDS();
    LAS unsigned char* lds = F.lds;
    const bf16* QKVG = (const bf16*)(F.ws + WS_QKVG); const f32x4* GS = (const f32x4*)(F.ws + WS_GS); bf16* Y2 = (bf16*)(F.ws + WS_Y2);
    const int wave = F.wave;
    for (int unit = F.vcu; unit < 256; unit += F.G) {
        const int bh = unit >> 4, g = unit & 15, b = bh >> 2, h = bh & 3;
        const int tb = b * SEQ + g * 256;
        ChunkRegs R; chunk_load<true>(F, tid, tb, h, R);
        load_w_image(F, tid, h);
        const f32x2 bb = *(const f32x2*)(F.in[9] + h * 128 + 2 * (tid & 63));
        v2u sg[2][4];
#define LOAD_SG(c_) do { _Pragma("unroll") for (int vt = 0; vt < 2; ++vt) _Pragma("unroll") for (int tt = 0; tt < 4; ++tt) sg[vt][tt] = *(const v2u*)(QKVG + (size_t)(tb + i15 + (c_) * 64 + 16 * tt) * NQKVG + 2048 + h * 256 + 32 * wave + 4 * q + 16 * vt); } while (0)
        f32x4 S[8][2];
        { const f32x4* gi = GS + ((size_t)(unit * 8 + wave) * 16) * 64 + lane;
#pragma unroll
          for (int kt = 0; kt < 8; ++kt)
#pragma unroll
              for (int vt = 0; vt < 2; ++vt) S[kt][vt] = (g == 0) ? (f32x4){0.f, 0.f, 0.f, 0.f} : gi[(kt * 2 + vt) * 64]; }
        LBAR();
        for (int c = 0; c < 4; ++c) {
            const int t0 = tb + c * 64;
            { int te = tid; asm volatile("" : "+v"(te)); (void)chunk_elem<true>(F, te, R, bb); }
            int tm = tid; asm volatile("" : "+v"(tm)); const int i15 = tm & 15, q = (tm >> 4) & 3;
#pragma unroll
            for (int e = 0; e < 2; ++e) { const int idx = wave * 2 + e, ti = idx >> 2, si = idx & 3;
                f32x4 af = (f32x4){0.f, 0.f, 0.f, 0.f}, ab = (f32x4){0.f, 0.f, 0.f, 0.f};
                const int ao = (si * 16 + i15) * C_ROW + q * 16, bo = (ti * 16 + i15) * C_ROW + q * 16;
                if (ti >= si) {
#pragma unroll
                    for (int kk = 0; kk < 4; ++kk) af = __builtin_amdgcn_mfma_f32_16x16x32_bf16(*(const LAS bf16x8*)(lds + C_KNS + ao + kk * 64), *(const LAS bf16x8*)(lds + C_QPS + bo + kk * 64), af, 0, 0, 0); }
                if (ti <= si) {
#pragma unroll
                    for (int kk = 0; kk < 4; ++kk) ab = __builtin_amdgcn_mfma_f32_16x16x32_bf16(*(const LAS bf16x8*)(lds + C_KPS + ao + kk * 64), *(const LAS bf16x8*)(lds + C_QNS + bo + kk * 64), ab, 0, 0, 0); }
                const int t = ti * 16 + i15; float v[4];
#pragma unroll
                for (int r = 0; r < 4; ++r) { const int s_ = si * 16 + 4 * q + r; v[r] = (s_ <= t) ? af[r] : ab[r]; }
                v2u o; o.x = pg8::cvt_pk_bf16(v[0], v[1]); o.y = pg8::cvt_pk_bf16(v[2], v[3]);
                *(LAS v2u*)(lds + C_SC + t * C_SCROW + (si * 16 + 4 * q) * 2) = o; }
            LBAR();
            if (c < 3) { int tl = tid; asm volatile("" : "+v"(tl)); chunk_load<true>(F, tl, t0 + 64, h, R); }
            LOAD_SG(c);
            f32x4 o[2][4];
#pragma unroll
            for (int vt = 0; vt < 2; ++vt)
#pragma unroll
                for (int tt = 0; tt < 4; ++tt) o[vt][tt] = (f32x4){0.f, 0.f, 0.f, 0.f};
            bf16x8 Vf[2][2];
#pragma unroll
            for (int vt = 0; vt < 2; ++vt)
#pragma unroll
                for (int ts = 0; ts < 2; ++ts) Vf[vt][ts] = tr_frag(lds + C_V, C_VROW, 32 * ts, 32 * wave + 16 * vt, i15, q);
#pragma unroll
            for (int tt = 0; tt < 4; ++tt)
#pragma unroll
                for (int ss = 0; ss < 2; ++ss) { const bf16x8 scf = *(const LAS bf16x8*)(lds + C_SC + (16 * tt + i15) * C_SCROW + (32 * ss + 8 * q) * 2);
                    o[0][tt] = __builtin_amdgcn_mfma_f32_16x16x32_bf16(Vf[0][ss], scf, o[0][tt], 0, 0, 0); o[1][tt] = __builtin_amdgcn_mfma_f32_16x16x32_bf16(Vf[1][ss], scf, o[1][tt], 0, 0, 0); }
#pragma unroll
            for (int ks = 0; ks < 4; ++ks) {
                bf16x8 SA[2];
#pragma unroll
                for (int vt = 0; vt < 2; ++vt) { const f32x4 sa = S[2 * ks][vt], sb = S[2 * ks + 1][vt];
                    v4u pk; pk.x = pg8::cvt_pk_bf16(sa[0], sa[1]); pk.y = pg8::cvt_pk_bf16(sa[2], sa[3]); pk.z = pg8::cvt_pk_bf16(sb[0], sb[1]); pk.w = pg8::cvt_pk_bf16(sb[2], sb[3]); SA[vt] = __builtin_bit_cast(bf16x8, pk); }
#pragma unroll
                for (int tt = 0; tt < 4; ++tt) {
                    const LAS unsigned char* qpp = lds + C_QPS + (16 * tt + i15) * C_ROW + (32 * ks + 4 * q) * 2;
                    const v2u lo = *(const LAS v2u*)qpp, hi = *(const LAS v2u*)(qpp + 32);
                    const bf16x8 qf = __builtin_bit_cast(bf16x8, (v4u){lo.x, lo.y, hi.x, hi.y});
                    o[0][tt] = __builtin_amdgcn_mfma_f32_16x16x32_bf16(SA[0], qf, o[0][tt], 0, 0, 0); o[1][tt] = __builtin_amdgcn_mfma_f32_16x16x32_bf16(SA[1], qf, o[1][tt], 0, 0, 0); } }
#pragma unroll
            for (int kt = 0; kt < 8; ++kt) { const f32x4 d = *(const LAS f32x4*)(lds + C_DEC + (16 * kt + 4 * q) * 4); S[kt][0] *= d; S[kt][1] *= d; }
#pragma unroll
            for (int ts = 0; ts < 2; ++ts)
#pragma unroll
                for (int kt = 0; kt < 8; ++kt) { const bf16x8 a = tr_frag(lds + C_KD, C_KDROW, 32 * ts, 16 * kt, i15, q);
                    S[kt][0] = __builtin_amdgcn_mfma_f32_16x16x32_bf16(a, Vf[0][ts], S[kt][0], 0, 0, 0); S[kt][1] = __builtin_amdgcn_mfma_f32_16x16x32_bf16(a, Vf[1][ts], S[kt][1], 0, 0, 0); }
            float pt[4];
#pragma unroll
            for (int tt = 0; tt < 4; ++tt) { float p = 0.f;
#pragma unroll
                for (int vt = 0; vt < 2; ++vt) p += (o[vt][tt][0] * o[vt][tt][0] + o[vt][tt][1] * o[vt][tt][1]) + (o[vt][tt][2] * o[vt][tt][2] + o[vt][tt][3] * o[vt][tt][3]);
                p += __shfl_xor(p, 16); p += __shfl_xor(p, 32); pt[tt] = p; }
            if (q == 0) {
#pragma unroll
                for (int tt = 0; tt < 4; ++tt) ((LAS float*)(lds + C_NRM))[wave * 64 + 16 * tt + i15] = pt[tt]; }
            LBAR();
            f32x4 hw[2];
#pragma unroll
            for (int vt = 0; vt < 2; ++vt) hw[vt] = *(const f32x4*)(F.in[10] + 32 * wave + 16 * vt + 4 * q);
#pragma unroll
            for (int tt = 0; tt < 4; ++tt) { float s_ = 0.f;
#pragma unroll
                for (int ww = 0; ww < 8; ++ww) s_ += ((const LAS float*)(lds + C_NRM))[ww * 64 + 16 * tt + i15];
                const float r = __builtin_amdgcn_rsqf(s_ * (1.f / 256.f) + EPS);
#pragma unroll
                for (int vt = 0; vt < 2; ++vt) { const f32x4 ov = o[vt][tt]; const v2u gg = sg[vt][tt];
                    v2u y; y.x = pg8::cvt_pk_bf16(ov[0] * r * hw[vt][0] * bflo(gg.x), ov[1] * r * hw[vt][1] * bfhi(gg.x)); y.y = pg8::cvt_pk_bf16(ov[2] * r * hw[vt][2] * bflo(gg.y), ov[3] * r * hw[vt][3] * bfhi(gg.y));
                    *(v2u*)(Y2 + (size_t)(t0 + 16 * tt + i15) * 1024 + h * 256 + 32 * wave + 16 * vt + 4 * q) = y; } }
            LBAR();
        }
#undef LOAD_SG
    }
}
__device__ __forceinline__ void phase_final(Frame& F) {
    PHASE_IDS();
    const float* ssq2 = (const float*)(F.ws + WS_SSQ2); const float* fw = F.in[12];
    const int gw = F.vcu * NWAVES + F.wave, NGW = F.G * NWAVES;
    f32x4 wv[4];
#pragma unroll
    for (int j = 0; j < 4; ++j) wv[j] = *((const f32x4*)fw + lane + 64 * j);
    for (int m = gw; m < M; m += NGW) { const float r = rstd_from4(ssq2, m);
        GAS f32x4* xr = (GAS f32x4*)(F.out + (size_t)m * D) + lane;
#pragma unroll
        for (int j = 0; j < 4; ++j) { f32x4 v = xr[64 * j]; v = v * r * wv[j]; xr[64 * j] = v; } }
}
struct Args { const float* in[13]; float* out; unsigned char* ws; int ph_lo, ph_hi, li, pad; };
__global__ void __launch_bounds__(NTHR, 2) mk_fwd(Args args) {
    extern __shared__ __attribute__((aligned(16))) unsigned char lds_raw[];
    Frame F;
    F.lds = (LAS unsigned char*)lds_raw;
    F.tid = threadIdx.x; F.lane = F.tid & 63; F.wave = __builtin_amdgcn_readfirstlane(F.tid >> 6);
    F.G = gridDim.x; { const int bx = blockIdx.x; F.vcu = (F.G % 8 == 0) ? (bx % 8) * (F.G / 8) + bx / 8 : bx; }
    F.ws = args.ws; F.out = args.out;
#pragma unroll
    for (int i = 0; i < 13; ++i) F.in[i] = args.in[i];
    volatile LAS unsigned* MISC = (volatile LAS unsigned*)(F.lds + MISC_OFF);
    for (int u = F.tid; u < (LDS_BYTES - LDSCTL_OFF) / 4; u += NTHR) ((LAS unsigned*)(F.lds + LDSCTL_OFF))[u] = 0u;
    __syncthreads();
    unsigned* ctl = (unsigned*)(F.ws + WS_CTL);
    const int lo = args.ph_lo, hi = args.ph_hi;
    XcdBarrier bar; bar.bar = ctl + CW_BAR + args.li * XCD_BAR_WORDS; bar.x = 0; bar.st = nullptr;
    if (hi - lo > 1) bar = xcd_barrier_post(ctl + CW_BAR + args.li * XCD_BAR_WORDS, MISC + 8);
#define IN(k) (lo <= (k) && (k) < hi)
#if PROBE_PHASE >= 0
#define STAMP(i) do { if (blockIdx.x == 0 && F.tid == 0) { const unsigned long long t_ = __builtin_amdgcn_s_memrealtime(); MISC[16 + 2 * (i)] = (unsigned)t_; MISC[17 + 2 * (i)] = (unsigned)(t_ >> 32); } } while (0)
#else
#define STAMP(i) do { } while (0)
#endif
#define SEAM(k) do { if (IN(k) && IN((k) + 1)) xcd_barrier(bar); STAMP((k) + 1); } while (0)
    STAMP(0);
    unsigned char* ws = F.ws;
    if (IN(0)) { phase_prep(F); } SEAM(0);
    if (IN(1)) { pg8::Gemm g{(const bf16*)(ws + WS_XB), (const bf16*)(ws + WS_W1T), 1024, 1024, 1024, 0}; pg8::StaticOrder S; S.init(M, 2048, F.G, (int)blockIdx.x);
        Epi1 E{(bf16*)(ws + WS_US), (const float*)(ws + WS_RSTD0)}; pg8::gemm_phase<Epi1, true>(F.lds, g, S, E); } SEAM(1);
    if (IN(2)) { phase_pool(F); } SEAM(2);
    if (IN(3)) { pg8::Gemm g{(const bf16*)(ws + WS_POOLED), (const bf16*)(ws + WS_GWT), 1024, 256, 256, 256}; pg8::StaticOrder S; S.init(M, 1024, F.G, (int)blockIdx.x);
        Epi2 E{(bf16*)(ws + WS_Y), (const bf16*)(ws + WS_US), F.in[4], F.in[5]}; pg8::gemm_phase<Epi2, true>(F.lds, g, S, E); } SEAM(3);
    if (IN(4)) { pg8::Gemm g{(const bf16*)(ws + WS_Y), (const bf16*)(ws + WS_W3T), 1024, 1024, 1024, 0}; pg8::StaticOrder S; S.init(M, 1024, F.G, (int)blockIdx.x);
        EpiRes<true> E{F.in[0], F.out, (bf16*)(ws + WS_H1B), (float*)(ws + WS_SSQ1)}; pg8::gemm_phase<EpiRes<true>, false>(F.lds, g, S, E); } SEAM(4);
    if (IN(5)) { pg8::Gemm g{(const bf16*)(ws + WS_H1B), (const bf16*)(ws + WS_W4T), 1024, 1024, 1024, 0}; pg8::StaticOrder S; S.init(M, NQKVG, F.G, (int)blockIdx.x);
        Epi4 E{(bf16*)(ws + WS_QKVG), (const float*)(ws + WS_SSQ1)}; pg8::gemm_phase<Epi4, true>(F.lds, g, S, E);
        phase_gklow(F); } SEAM(5);
    if (IN(6)) { phase_gla_a(F); } SEAM(6);
    if (IN(7)) { phase_gla_b(F); } SEAM(7);
    if (IN(8)) { phase_gla_c(F); } SEAM(8);
    if (IN(9)) { pg8::Gemm g{(const bf16*)(ws + WS_Y2), (const bf16*)(ws + WS_W6T), 1024, 1024, 1024, 0}; pg8::StaticOrder S; S.init(M, 1024, F.G, (int)blockIdx.x);
        EpiRes<false> E{F.out, F.out, nullptr, (float*)(ws + WS_SSQ2)}; pg8::gemm_phase<EpiRes<false>, false>(F.lds, g, S, E); } SEAM(9);
    if (IN(10)) { phase_final(F); }
#if PROBE_PHASE >= 0
    VM_WAIT(); __syncthreads(); STAMP(11);
    if (blockIdx.x == 0 && F.tid == 0) {
        const unsigned long long a_ = ((unsigned long long)MISC[17 + 2 * PROBE_PHASE] << 32) | MISC[16 + 2 * PROBE_PHASE], b_ = ((unsigned long long)MISC[17 + 2 * (PROBE_PHASE + 1)] << 32) | MISC[16 + 2 * (PROBE_PHASE + 1)];
        const unsigned long long dt_ = (b_ - a_) * 8ull, t0_ = __builtin_amdgcn_s_memrealtime();
        while (__builtin_amdgcn_s_memrealtime() - t0_ < dt_) __builtin_amdgcn_s_sleep(8);
    }
#endif
#undef IN
#undef SEAM
}
#if DBG
namespace dbg {
constexpr int ROWS = 512;
__global__ void __launch_bounds__(256) k_cmp(const void* fast, int is_bf16, int mode, long fs, long fo, const float* refp, long rs, long ro, int rows, int cols, int tr, unsigned* slots, int slot) {
    const long i = (long)blockIdx.x * 256 + threadIdx.x;
    float err = 0.f, mag = 0.f;
    if (i < (long)rows * cols) {
        const long r = i / cols, c = i % cols;
        long fi = r * fs + fo + c;
        if (mode == 1) { const long h = c >> 7, k = c & 127; fi = ((r >> 6) * 4 + h) * 8192 + k * 64 + (r & 63); }
        float a = is_bf16 ? __builtin_bit_cast(float, (unsigned)((const unsigned short*)fast)[fi] << 16) : ((const float*)fast)[fi];
        float b = refp[r * rs + ro + c];
        if (tr == 1) b = b / (1.f + __expf(-b)); else if (tr == 2) b *= 0.08838834764831845f;
        err = fabsf(a - b); mag = fabsf(b);
        if (!(err == err) || err > 3.0e38f) err = 3.0e38f;
    }
#pragma unroll
    for (int o = 1; o < 64; o <<= 1) { err = fmaxf(err, __shfl_xor(err, o)); mag = fmaxf(mag, __shfl_xor(mag, o)); }
    if ((threadIdx.x & 63) == 0) { atomicMax(slots + 2 * slot, __builtin_bit_cast(unsigned, err)); atomicMax(slots + 2 * slot + 1, __builtin_bit_cast(unsigned, mag)); }
}
__global__ void __launch_bounds__(256) k_encode(float* out, long n, const unsigned* slots, int nslots, int only_slot) {
    const long i = (long)blockIdx.x * 256 + threadIdx.x;
    if (i >= n) return;
    float v = 0.f;
    if (i == 0) {
        v = 990000.f;
        for (int s = 1; s < nslots; ++s) {
            const float err = __builtin_bit_cast(float, slots[2 * s]), mag = __builtin_bit_cast(float, slots[2 * s + 1]);
            const float rel = err / fmaxf(mag, 1e-20f);
            if (only_slot > 0) { if (s == only_slot) { v = rel * 1.0e6f + 1.0e4f; break; } continue; }
            int sev = 0;
            if (!(rel < 0.03f)) sev = rel < 0.1f ? 1 : rel < 0.3f ? 2 : rel < 1.f ? 3 : rel < 1e30f ? 4 : 5;
            if (mag == 0.f) sev = 6;
            if (sev) { v = (float)(10 * s + sev) * 1.0e4f; break; }
        }
    }
    out[i] = v;
}
}
#endif

extern "C" void kernel_launch(void* const* d_in, const int* in_sizes, int n_in, void* d_out, int out_size, void* d_ws, size_t ws_size, hipStream_t stream) {
    static int grid = 0;
    if (grid == 0) {
        if (n_in != 13 || in_sizes[0] != M * D || out_size != M * D || ws_size < WS_END) { fprintf(stderr, "kernel_launch: unexpected problem shape (n_in %d, in0 %d, out %d, ws %zu)\n", n_in, n_in > 0 ? in_sizes[0] : -1, out_size, ws_size); grid = -1; return; }
        int dev = 0, cus = 0, per_cu = 0;
        if (hipGetDevice(&dev) != hipSuccess || hipDeviceGetAttribute(&cus, hipDeviceAttributeMultiprocessorCount, dev) != hipSuccess) { grid = -1; return; }
        if (hipFuncSetAttribute((const void*)mk_fwd, hipFuncAttributeMaxDynamicSharedMemorySize, LDS_BYTES) != hipSuccess) { fprintf(stderr, "kernel_launch: hipFuncSetAttribute failed\n"); grid = -1; return; }
        if (hipOccupancyMaxActiveBlocksPerMultiprocessor(&per_cu, (const void*)mk_fwd, NTHR, LDS_BYTES) != hipSuccess || per_cu < 1) { fprintf(stderr, "kernel_launch: occupancy query says %d workgroups per CU\n", per_cu); (void)hipGetLastError(); grid = -1; return; }
        grid = cus;
    }
    if (grid < 0) return;
    (void)hipMemsetAsync((char*)d_ws + WS_CTL, 0, CTL_ZERO_BYTES, stream);
    Args a{};
    for (int i = 0; i < 13; ++i) a.in[i] = (const float*)d_in[i];
    a.out = (float*)d_out; a.ws = (unsigned char*)d_ws;
#if !DBG
    a.ph_lo = 0; a.ph_hi = NPH; a.li = 0;
    hipLaunchKernelGGL(mk_fwd, dim3(grid), dim3(NTHR), LDS_BYTES, stream, a);
#else
    unsigned char* ws = (unsigned char*)d_ws; hipStream_t st = stream;
    const int R = dbg::ROWS;
    float* rb = (float*)(ws + WS_DBG);
    size_t off = 0; auto take = [&](size_t nfl) { float* p = rb + off; off += (nfl + 63) & ~(size_t)63; return p; };
    float* P0 = take((size_t)R * 2048), *pooled = take((size_t)R * 1024), *y = take((size_t)R * 1024), *h1 = take((size_t)R * 1024), *proj = take((size_t)R * 3088), *cum = take((size_t)R * 512);
    float* qp = take((size_t)R * 512), *qn = take((size_t)R * 512), *kp = take((size_t)R * 512), *kn = take((size_t)R * 512), *kd = take((size_t)R * 512);
    float* scores = take((size_t)(R / 64) * 4 * 4096), *decay = take((size_t)(R / 64) * 512), *o = take((size_t)R * 1024), *y2 = take((size_t)R * 1024), *h2 = take((size_t)R * 1024), *outr = take((size_t)R * 1024), *rstd = take(R);
    {
        using namespace ref;
        const float* x = (const float*)d_in[0]; const float* norm_w = (const float*)d_in[1];
        auto gemm = [&](const float* A, int lda, const float* B, int ldb, float* C, int ldc, int Mr, int N, int K, const float* rs, const float* ks, const float* Rr, int ldr) {
            k_gemm<<<dim3((N + 63) / 64, Mr / 64), 256, 0, st>>>(A, lda, B, ldb, C, ldc, Mr, N, K, rs, ks, Rr, ldr); };
        k_rstd<<<R / 4, 256, 0, st>>>(x, rstd, R);
        gemm(x, 1024, (const float*)d_in[2], 2048, P0, 2048, R, 2048, 1024, rstd, norm_w, nullptr, 0);
        k_pool<<<(R * 1024) / 256, 256, 0, st>>>(P0, pooled, R);
        for (int g = 0; g < 4; ++g) gemm(pooled + g * 256, 1024, (const float*)d_in[3] + (size_t)g * 65536, 256, y + g * 256, 1024, R, 256, 256, nullptr, nullptr, nullptr, 0);
        k_gate0<<<(R * 1024) / 256, 256, 0, st>>>(y, P0, (const float*)d_in[4], (const float*)d_in[5], R);
        gemm(y, 1024, (const float*)d_in[6], 1024, h1, 1024, R, 1024, 1024, nullptr, nullptr, x, 1024);
        k_rstd<<<R / 4, 256, 0, st>>>(h1, rstd, R);
        gemm(h1, 1024, (const float*)d_in[7], 3088, proj, 3088, R, 3088, 1024, rstd, norm_w + 1024, nullptr, 0);
        k_cum<<<((R / 64) * 512) / 256, 256, 0, st>>>(proj, (const float*)d_in[8], (const float*)d_in[9], cum, R / 64);
        k_prep<<<(R * 512) / 256, 256, 0, st>>>(proj, cum, qp, qn, kp, kn, kd, decay, R);
        k_scores<<<(R / 64) * 4, 256, 0, st>>>(qp, qn, kp, kn, scores);
        k_gla_seq<<<64, 256, 0, st>>>(qp, kd, scores, decay, proj, o, R / 64);
        (void)hipMemcpyAsync(y2, o, (size_t)R * 1024 * 4, hipMemcpyDeviceToDevice, st);
        k_headnorm<<<R, 256, 0, st>>>(y2, proj, (const float*)d_in[10], R);
        gemm(y2, 1024, (const float*)d_in[11], 1024, h2, 1024, R, 1024, 1024, nullptr, nullptr, h1, 1024);
        (void)hipMemcpyAsync(outr, h2, (size_t)R * 1024 * 4, hipMemcpyDeviceToDevice, st);
        k_final<<<R / 4, 256, 0, st>>>(outr, (const float*)d_in[12], R);
    }
    unsigned* slots = (unsigned*)(ws + WS_CTL) + 2048;
    auto cmp = [&](const void* fast, int is_bf16, int mode, long fs, long fo, const float* refp, long rs, long ro, int rows, int cols, int tr, int slot) {
        dbg::k_cmp<<<(unsigned)(((long)rows * cols + 255) / 256), 256, 0, st>>>(fast, is_bf16, mode, fs, fo, refp, rs, ro, rows, cols, tr, slots, slot); };
    auto run = [&](int lo, int hi, int li) { a.ph_lo = lo; a.ph_hi = hi; a.li = li; hipLaunchKernelGGL(mk_fwd, dim3(grid), dim3(NTHR), LDS_BYTES, st, a); };
#if DBG == 1
    run(0, 1, 0); run(1, 2, 0);
    cmp(ws + WS_US, 1, 0, 2048, 0, P0, 2048, 0, R, 1024, 0, 1);
    cmp(ws + WS_US, 1, 0, 2048, 1024, P0, 2048, 1024, R, 1024, 1, 2);
    run(2, 3, 0); cmp(ws + WS_POOLED, 1, 0, 1024, 0, pooled, 1024, 0, R, 1024, 0, 3);
    run(3, 4, 0); cmp(ws + WS_Y, 1, 0, 1024, 0, y, 1024, 0, R, 1024, 0, 4);
    run(4, 5, 0); cmp(d_out, 0, 0, 1024, 0, h1, 1024, 0, R, 1024, 0, 5); cmp(ws + WS_H1B, 1, 0, 1024, 0, h1, 1024, 0, R, 1024, 0, 6);
    run(5, 6, 0);
    cmp(ws + WS_QKVG, 1, 0, 3072, 0, proj, 3088, 0, R, 512, 2, 7);
    cmp(ws + WS_QKVG, 1, 0, 3072, 512, proj, 3088, 512, R, 1536, 0, 8);
    cmp(ws + WS_QKVG, 1, 0, 3072, 2048, proj, 3088, 2048, R, 1024, 1, 9);
    cmp(ws + WS_GKL, 0, 0, 16, 0, proj, 3088, 3072, R, 16, 0, 10);
    run(6, 7, 0); run(7, 8, 0);
    run(8, 9, 0); cmp(ws + WS_Y2, 1, 0, 1024, 0, y2, 1024, 0, R, 1024, 0, 16);
    run(9, 10, 0); cmp(d_out, 0, 0, 1024, 0, h2, 1024, 0, R, 1024, 0, 17);
    run(10, 11, 0); cmp(d_out, 0, 0, 1024, 0, outr, 1024, 0, R, 1024, 0, 18);
#else
    run(0, NPH, 0);
    cmp(ws + WS_Y2, 1, 0, 1024, 0, y2, 1024, 0, R, 1024, 0, 16);
    cmp(d_out, 0, 0, 1024, 0, outr, 1024, 0, R, 1024, 0, 18);
#endif
    dbg::k_encode<<<(unsigned)(((long)M * D + 255) / 256), 256, 0, st>>>((float*)d_out, (long)M * D, slots, 19, DBG_ONLY);
#endif
}
```
